# Optimizing an MI355X kernel written in HIP

```python
import numpy as np
import jax, jax.numpy as jnp
from jax import lax

D_MODEL = 2048
BATCH = 8
SEQ = 4096
DEPTH = 4

ATTN_HEADS = 16
ATTN_KV_HEADS = 4
ATTN_GROUP = ATTN_HEADS // ATTN_KV_HEADS
ATTN_HEAD_DIM = 128
WINDOW = 128
ATTN_BLOCK = 128
ROPE_THETA = 500000.0
ROT_DIM = ATTN_HEAD_DIM // 4
DN_HEADS = 16
DN_KEY_DIM = 128
DN_VALUE_DIM = 128
DN_CONV = 4
DN_CHUNK = 64
D_FF = 11 * D_MODEL // 4
FFN_CONV = 3
EPS = 1e-6

ATTN_Q_W = ATTN_HEADS * ATTN_HEAD_DIM
ATTN_KV_W = ATTN_KV_HEADS * ATTN_HEAD_DIM
DN_K_W = DN_HEADS * DN_KEY_DIM
DN_V_W = DN_HEADS * DN_VALUE_DIM
DN_QKV_W = 2 * DN_K_W + DN_V_W
IN_SPLITS = (ATTN_Q_W, ATTN_KV_W, ATTN_KV_W, DN_QKV_W, DN_HEADS, DN_HEADS, DN_V_W, D_MODEL, D_MODEL)
IN_WIDTH = sum(IN_SPLITS)

kernel_name = "hybrid_swa_sink_gdn_convglu_sandwich"


def rms_norm(x, w):
    xf = x.astype(jnp.float32)
    y = xf * lax.rsqrt(jnp.mean(xf * xf, axis=-1, keepdims=True) + EPS)
    return (y * w.astype(jnp.float32)).astype(x.dtype)


def l2_norm(x):
    return x * lax.rsqrt(jnp.sum(x * x, axis=-1, keepdims=True) + EPS)


def causal_depthwise_conv(x, w):
    k_width = w.shape[0]
    s = x.shape[1]
    xp = jnp.pad(x, ((0, 0), (k_width - 1, 0), (0, 0)))
    y = xp[:, 0:s] * w[0]
    for j in range(1, k_width):
        y = y + xp[:, j:j + s] * w[j]
    return y


def rope_tables(positions):
    inv_freq = ROPE_THETA ** (-jnp.arange(0, ROT_DIM, 2, dtype=jnp.float32) / ROT_DIM)
    ang = positions.astype(jnp.float32)[..., None] * inv_freq
    return jnp.cos(ang)[:, :, None, :], jnp.sin(ang)[:, :, None, :]


def partial_rope(x, cos, sin):
    half = ROT_DIM // 2
    x1 = x[..., :half].astype(jnp.float32)
    x2 = x[..., half:ROT_DIM].astype(jnp.float32)
    r1 = (x1 * cos - x2 * sin).astype(x.dtype)
    r2 = (x2 * cos + x1 * sin).astype(x.dtype)
    return jnp.concatenate([r1, r2, x[..., ROT_DIM:]], axis=-1)


def sliding_window_attention(q, k, v, sinks):
    b, s = q.shape[0], q.shape[1]
    nb = s // ATTN_BLOCK
    qb = q.reshape(b, nb, ATTN_BLOCK, ATTN_KV_HEADS, ATTN_GROUP, ATTN_HEAD_DIM).transpose(1, 0, 2, 3, 4, 5)

    def band(t):
        tb = t.reshape(b, nb, ATTN_BLOCK, ATTN_KV_HEADS, ATTN_HEAD_DIM)
        prev = jnp.concatenate([jnp.zeros_like(tb[:, :1]), tb[:, :-1]], axis=1)
        return jnp.concatenate([prev, tb], axis=2).transpose(1, 0, 2, 3, 4)

    kb, vb = band(k), band(v)
    r = jnp.arange(ATTN_BLOCK)[:, None]
    c = jnp.arange(2 * ATTN_BLOCK)[None, :]
    dist = r + ATTN_BLOCK - c
    in_band = (dist >= 0) & (dist < WINDOW)
    sink = sinks.astype(jnp.float32).reshape(ATTN_KV_HEADS, ATTN_GROUP)[None, :, :, None, None]
    scale = ATTN_HEAD_DIM ** -0.5

    def one_block(args):
        qi, ki, vi, bi = args
        logits = jnp.einsum('bqkgd,bckd->bkgqc', qi, ki).astype(jnp.float32) * scale
        valid = in_band & ((bi * ATTN_BLOCK - ATTN_BLOCK + c) >= 0)
        logits = jnp.where(valid, logits, -jnp.inf)
        m = jnp.maximum(jnp.max(logits, axis=-1, keepdims=True), sink)
        p = jnp.exp(logits - m)
        denom = jnp.sum(p, axis=-1, keepdims=True) + jnp.exp(sink - m)
        return jnp.einsum('bkgqc,bckd->bqkgd', (p / denom).astype(vi.dtype), vi)

    out = lax.map(one_block, (qb, kb, vb, jnp.arange(nb)))
    return out.transpose(1, 0, 2, 3, 4, 5).reshape(b, s, ATTN_Q_W)


def gated_delta_rule(q, k, v, beta, g):
    b, s, h, _ = q.shape
    nc = s // DN_CHUNK
    q = l2_norm(q) * (DN_KEY_DIM ** -0.5)
    k = l2_norm(k)

    def chunks(t):
        return t.reshape(b, nc, DN_CHUNK, h, t.shape[-1]).transpose(0, 1, 3, 2, 4)

    q, k, v = chunks(q), chunks(k), chunks(v)
    beta = beta.reshape(b, nc, DN_CHUNK, h).transpose(0, 1, 3, 2)
    g = jnp.cumsum(g.reshape(b, nc, DN_CHUNK, h).transpose(0, 1, 3, 2), axis=-1)
    tri = jnp.tril(jnp.ones((DN_CHUNK, DN_CHUNK), dtype=bool))
    strict = jnp.tril(jnp.ones((DN_CHUNK, DN_CHUNK), dtype=bool), -1)
    decay = jnp.exp(jnp.where(tri, g[..., :, None] - g[..., None, :], -jnp.inf))
    kk = jnp.einsum('bnhid,bnhjd->bnhij', k, k)
    a_mat = jnp.where(strict, beta[..., :, None] * kk * decay, 0.0)
    eye = jnp.eye(DN_CHUNK, dtype=jnp.float32)
    t_inv = lax.linalg.triangular_solve(eye + a_mat, jnp.broadcast_to(eye, a_mat.shape),
                                        left_side=True, lower=True, unit_diagonal=True)
    u = jnp.einsum('bnhij,bnhjd->bnhid', t_inv, v * beta[..., None])
    w = jnp.einsum('bnhij,bnhjd->bnhid', t_inv, k * (beta * jnp.exp(g))[..., None])
    qk = jnp.where(tri, jnp.einsum('bnhid,bnhjd->bnhij', q, k) * decay, 0.0)

    def step(state, inp):
        qc, kc, uc, wc, gc, qkc = inp
        v_new = uc - jnp.einsum('bhcd,bhde->bhce', wc, state)
        o = (jnp.einsum('bhcd,bhde->bhce', qc * jnp.exp(gc)[..., None], state)
             + jnp.einsum('bhij,bhje->bhie', qkc, v_new))
        g_last = gc[..., -1]
        state = (state * jnp.exp(g_last)[..., None, None]
                 + jnp.einsum('bhcd,bhce->bhde', kc * jnp.exp(g_last[..., None] - gc)[..., None], v_new))
        return state, o

    xs = tuple(jnp.moveaxis(t, 1, 0) for t in (q, k, u, w, g, qk))
    state0 = jnp.zeros((b, h, DN_KEY_DIM, DN_VALUE_DIM), jnp.float32)
    _, o = lax.scan(step, state0, xs)
    return o.transpose(1, 0, 3, 2, 4).reshape(b, s, h, DN_VALUE_DIM)


def hybrid_mixer(xn, cos, sin, w_in, sinks, dn_conv_w, dn_a_log, dn_dt_bias, dn_norm_w,
                 w_branch_attn, w_branch_dn, w_out):
    b, s, _ = xn.shape
    proj = xn @ w_in
    idx = np.cumsum(IN_SPLITS)[:-1].tolist()
    q_a, k_a, v_a, qkv_d, b_d, a_d, z_d, g_a, g_d = jnp.split(proj, idx, axis=-1)

    q_a = partial_rope(q_a.reshape(b, s, ATTN_HEADS, ATTN_HEAD_DIM), cos, sin)
    k_a = partial_rope(k_a.reshape(b, s, ATTN_KV_HEADS, ATTN_HEAD_DIM), cos, sin)
    v_a = v_a.reshape(b, s, ATTN_KV_HEADS, ATTN_HEAD_DIM)
    o_a = sliding_window_attention(q_a, k_a, v_a, sinks)

    qkv_d = jax.nn.silu(causal_depthwise_conv(qkv_d, dn_conv_w)).astype(jnp.float32)
    q_d, k_d, v_d = jnp.split(qkv_d, [DN_K_W, 2 * DN_K_W], axis=-1)
    beta = jax.nn.sigmoid(b_d.astype(jnp.float32))
    g = -jnp.exp(dn_a_log.astype(jnp.float32)) * jax.nn.softplus(b_d.dtype.type(1) * a_d.astype(jnp.float32) + dn_dt_bias.astype(jnp.float32))
    o_d = gated_delta_rule(q_d.reshape(b, s, DN_HEADS, DN_KEY_DIM), k_d.reshape(b, s, DN_HEADS, DN_KEY_DIM),
                           v_d.reshape(b, s, DN_HEADS, DN_VALUE_DIM), beta, g)
    z = z_d.reshape(b, s, DN_HEADS, DN_VALUE_DIM).astype(jnp.float32)
    o_d = (o_d * lax.rsqrt(jnp.mean(o_d * o_d, axis=-1, keepdims=True) + EPS)
           * dn_norm_w.astype(jnp.float32) * jax.nn.silu(z))
    o_d = o_d.reshape(b, s, DN_V_W).astype(xn.dtype)

    y = jax.nn.sigmoid(g_a) * (o_a @ w_branch_attn) + jax.nn.sigmoid(g_d) * (o_d @ w_branch_dn)
    return y @ w_out


def conv_glu_ffn(xn, w_up, conv_w, conv_b, w_down):
    u = causal_depthwise_conv(xn @ w_up, conv_w) + conv_b
    gate, val = jnp.split(u, 2, axis=-1)
    return (jax.nn.silu(gate) * val) @ w_down


def setup_inputs(seed: int = 0) -> dict:
    key = jax.random.key(seed)
    ks = jax.random.split(key, 20)
    f32 = jnp.float32
    L, D = DEPTH, D_MODEL

    def normal(k, shape, scale):
        return jax.random.normal(k, shape, f32) * scale

    def gain(k, shape):
        return 1.0 + 0.02 * jax.random.normal(k, shape, f32)

    x = normal(ks[0], (BATCH, SEQ, D), 1.0)
    positions = (jax.random.randint(ks[1], (BATCH, 1), 0, 4096, dtype=jnp.int32)
                 + jnp.arange(SEQ, dtype=jnp.int32)[None, :])
    dt = jnp.exp(jax.random.uniform(ks[7], (L, DN_HEADS), f32, np.log(1e-3), np.log(1e-1)))
    return {
        "x": x,
        "positions": positions,
        "norm_mix_pre": gain(ks[2], (L, D)),
        "w_in": normal(ks[3], (L, D, IN_WIDTH), D ** -0.5),
        "attn_sinks": normal(ks[4], (L, ATTN_HEADS), 1.0),
        "dn_conv_w": normal(ks[5], (L, DN_CONV, DN_QKV_W), DN_CONV ** -0.5),
        "dn_a_log": jnp.log(jax.random.uniform(ks[6], (L, DN_HEADS), f32, 1.0, 16.0)),
        "dn_dt_bias": dt + jnp.log(-jnp.expm1(-dt)),
        "dn_norm_w": gain(ks[8], (L, DN_VALUE_DIM)),
        "w_branch_attn": normal(ks[9], (L, ATTN_Q_W, D), ATTN_Q_W ** -0.5),
        "w_branch_dn": normal(ks[10], (L, DN_V_W, D), DN_V_W ** -0.5),
        "w_out": normal(ks[11], (L, D, D), D ** -0.5),
        "norm_mix_post": gain(ks[12], (L, D)),
        "norm_ffn_pre": gain(ks[13], (L, D)),
        "w_ffn_up": normal(ks[14], (L, D, 2 * D_FF), D ** -0.5),
        "ffn_conv_w": normal(ks[15], (L, FFN_CONV, 2 * D_FF), FFN_CONV ** -0.5),
        "ffn_conv_b": normal(ks[16], (L, 2 * D_FF), 0.01),
        "w_ffn_down": normal(ks[17], (L, D_FF, D), D_FF ** -0.5),
        "norm_ffn_post": gain(ks[18], (L, D)),
    }


def reference(x, positions, norm_mix_pre, w_in, attn_sinks, dn_conv_w, dn_a_log, dn_dt_bias, dn_norm_w,
              w_branch_attn, w_branch_dn, w_out, norm_mix_post, norm_ffn_pre, w_ffn_up, ffn_conv_w,
              ffn_conv_b, w_ffn_down, norm_ffn_post):
    cos, sin = rope_tables(positions)
    h = x
    for l in range(DEPTH):
        xn = rms_norm(h, norm_mix_pre[l])
        mix = hybrid_mixer(xn, cos, sin, w_in[l], attn_sinks[l], dn_conv_w[l], dn_a_log[l], dn_dt_bias[l],
                           dn_norm_w[l], w_branch_attn[l], w_branch_dn[l], w_out[l])
        h = h + rms_norm(mix, norm_mix_post[l])
        xf = rms_norm(h, norm_ffn_pre[l])
        f = conv_glu_ffn(xf, w_ffn_up[l], ffn_conv_w[l], ffn_conv_b[l], w_ffn_down[l])
        h = h + rms_norm(f, norm_ffn_post[l])
    return h
```

```cpp
#include <hip/hip_runtime.h>
#include <cstdio>
#include <cstdint>

#ifndef MK_ONE_LAUNCH
#define MK_ONE_LAUNCH 1
#endif

typedef __bf16 bf16x2n_t __attribute__((ext_vector_type(2)));
typedef float f32x2n_t __attribute__((ext_vector_type(2)));
__device__ __forceinline__ unsigned pk2(float lo, float hi) { f32x2n_t v = {lo, hi}; return __builtin_bit_cast(unsigned, __builtin_convertvector(v, bf16x2n_t)); }
__device__ __forceinline__ float bf_lo(unsigned w) { return __uint_as_float(w << 16); }
__device__ __forceinline__ float bf_hi(unsigned w) { return __uint_as_float(w & 0xffff0000u); }
__device__ __forceinline__ float bf1(unsigned short h) { return __uint_as_float(((unsigned)h) << 16); }
__device__ __forceinline__ float sigmoidf_(float x) { return __builtin_amdgcn_rcpf(1.0f + __expf(-x)); }
__device__ __forceinline__ float siluf_(float x) { return x * __builtin_amdgcn_rcpf(1.0f + __expf(-x)); }

namespace pg8 {
#define PG8_LAS __attribute__((address_space(3)))
typedef unsigned short bf16_t;
typedef short bf16x8 __attribute__((ext_vector_type(8)));
typedef float f32x4 __attribute__((ext_vector_type(4)));
typedef unsigned u32x4 __attribute__((ext_vector_type(4)));
constexpr int BM = 256, BK = 64, HALF = 128, HTB = HALF * BK * 2  , STAGE_BYTES = 8 * HTB, NXCD = 8, WGM = 8;

__host__ __device__ __forceinline__ int lds_byte(int r, int c) { const int st = (r >> 4) * 2 + (c >> 5), rr = r & 15, cc = c & 31, ob = rr * 64 + cc * 2; return st * 1024 + (ob ^ (((ob >> 9) & 1) << 5)); }
__host__ __device__ __forceinline__ void stage_rc(int b, int& R, int& C) { const int st = b / 1024, sb = b % 1024, swz = sb ^ (((sb >> 9) & 1) << 5); R = (st >> 1) * 16 + swz / 64; C = (st & 1) * 32 + (swz % 64) / 2; }
__host__ __device__ __forceinline__ int perm32(int rho) { const int n = rho >> 4, i = rho & 15; return 8 * (i >> 2) + 4 * n + (i & 3); }

struct Unit { int pm, pn; };
struct Gemm { const bf16_t* A; const bf16_t* Bt; int M, N, K; };

struct StaticOrder {
    int nM, nN, nwg, G, c, wgm;
    __host__ __device__ void init(int M, int N, int G_, int c_, int wgm_ = 4) { nM = M / BM; nN = N / BM; nwg = nM * nN; G = G_; c = c_; wgm = wgm_; }
    __host__ __device__ bool next(int i, Unit& u) const {
        const long L = (long)i * G + c; if (L >= nwg) return false;
        int wgid = (int)L; { const int q = nwg / NXCD, r = nwg % NXCD, xcd = wgid % NXCD, off = wgid / NXCD; wgid = (xcd < r ? xcd * (q + 1) : r * (q + 1) + (xcd - r) * q) + off; }
        const int nig = wgm * nN, gid = wgid / nig, fm = gid * wgm, gsz = (nM - fm) < wgm ? (nM - fm) : wgm;
        u.pm = fm + ((wgid % nig) % gsz); u.pn = (wgid % nig) / gsz; return true;
    }
    __device__ __forceinline__ void a_ready(const Unit&) const {}
    __device__ __forceinline__ void done(const Unit&) const {}
};

__device__ __forceinline__ u32x4 pack8v(const f32x4 v0, const f32x4 v1) { u32x4 w; w.x = pk2(v0[0], v0[1]); w.y = pk2(v0[2], v0[3]); w.z = pk2(v1[0], v1[1]); w.w = pk2(v1[2], v1[3]); return w; }
__device__ __forceinline__ void unpack8v(const u32x4 w, f32x4& v0, f32x4& v1) { v0[0] = bf_lo(w.x); v0[1] = bf_hi(w.x); v0[2] = bf_lo(w.y); v0[3] = bf_hi(w.y); v1[0] = bf_lo(w.z); v1[1] = bf_hi(w.z); v1[2] = bf_lo(w.w); v1[3] = bf_hi(w.w); }

struct EpiPlain {
    static constexpr bool PERM = true, AFTER_DRAIN = false;
    bf16_t* O; int ldc;
    __device__ __forceinline__ void operator()(const f32x4 (&acc)[2][2][4][2], const Unit& u, int wr, int wc, int fr, int fq) const {
        const int row0 = u.pm * BM + wr * 64 + fr, col0 = u.pn * BM + wc * 32 + 8 * fq;
#pragma unroll
        for (int ai = 0; ai < 2; ++ai)
#pragma unroll
            for (int m = 0; m < 4; ++m) { bf16_t* rowp = O + (size_t)(row0 + ai * HALF + m * 16) * ldc + col0;
#pragma unroll
                for (int bj = 0; bj < 2; ++bj) *(u32x4*)(rowp + bj * HALF) = pack8v(acc[ai][bj][m][0], acc[ai][bj][m][1]); }
    }
};

struct EpiInProj {
    static constexpr bool PERM = true, AFTER_DRAIN = false;
    bf16_t *QA, *KA, *VA, *QKVD, *ZD, *GA, *GD; float* BAf; const float* rope;
    __device__ __forceinline__ void operator()(const f32x4 (&acc)[2][2][4][2], const Unit& u, int wr, int wc, int fr, int fq) const {
        const int pn = u.pn; const int row0 = u.pm * BM + wr * 64 + fr;
        if (pn == 60) {
            if (wc == 0) {
#pragma unroll
                for (int ai = 0; ai < 2; ++ai)
#pragma unroll
                    for (int m = 0; m < 4; ++m) { float* p = BAf + (size_t)(row0 + ai * HALF + m * 16) * 32 + 8 * fq; *(f32x4*)p = acc[ai][0][m][0]; *(f32x4*)(p + 4) = acc[ai][0][m][1]; }
            }
            return;
        }
        bf16_t* base; int ldc, colt; bool rope_on = false;
        if (pn < 8) { base = QA; ldc = 2048; colt = pn * 256; rope_on = true; }
        else if (pn < 10) { base = KA; ldc = 512; colt = (pn - 8) * 256; rope_on = true; }
        else if (pn < 12) { base = VA; ldc = 512; colt = (pn - 10) * 256; }
        else if (pn < 36) { base = QKVD; ldc = 6144; colt = (pn - 12) * 256; }
        else if (pn < 44) { base = ZD; ldc = 2048; colt = (pn - 36) * 256; }
        else if (pn < 52) { base = GA; ldc = 2048; colt = (pn - 44) * 256; }
        else { base = GD; ldc = 2048; colt = (pn - 52) * 256; }
        const int col0 = colt + wc * 32 + 8 * fq;
        const bool do_rope = rope_on && (wc == 0);
        const float sg = (fq < 2) ? -1.f : 1.f;
#pragma unroll
        for (int ai = 0; ai < 2; ++ai)
#pragma unroll
            for (int m = 0; m < 4; ++m) { const int row = row0 + ai * HALF + m * 16; bf16_t* rowp = base + (size_t)row * ldc + col0;
                f32x4 c0 = {1.f, 1.f, 1.f, 1.f}, c1 = c0, s0 = {0.f, 0.f, 0.f, 0.f}, s1 = s0;
                if (do_rope) { const float* rp = rope + (size_t)row * 32 + 8 * (fq & 1); c0 = *(const f32x4*)rp; c1 = *(const f32x4*)(rp + 4); s0 = *(const f32x4*)(rp + 16); s1 = *(const f32x4*)(rp + 20); }
#pragma unroll
                for (int bj = 0; bj < 2; ++bj) { f32x4 v0 = acc[ai][bj][m][0], v1 = acc[ai][bj][m][1];
                    if (do_rope) { f32x4 p0, p1;
#pragma unroll
                        for (int e = 0; e < 4; ++e) { p0[e] = __shfl_xor(v0[e], 32); p1[e] = __shfl_xor(v1[e], 32); }
                        v0 = v0 * c0 + sg * (p0 * s0); v1 = v1 * c1 + sg * (p1 * s1); }
                    *(u32x4*)(rowp + bj * HALF) = pack8v(v0, v1); } }
    }
};

template <int MODE> struct EpiGate {
    static constexpr bool PERM = true, AFTER_DRAIN = false;
    bf16_t* Y; const bf16_t* G;
    __device__ __forceinline__ void operator()(const f32x4 (&acc)[2][2][4][2], const Unit& u, int wr, int wc, int fr, int fq) const {
        const int row0 = u.pm * BM + wr * 64 + fr, col0 = u.pn * BM + wc * 32 + 8 * fq;
        const size_t off0 = (size_t)row0 * 2048 + col0;
        u32x4 gn = *(const u32x4*)(G + off0), yn = {0u, 0u, 0u, 0u};
        if (MODE == 1) yn = *(const u32x4*)(Y + off0);
#pragma unroll
        for (int k = 0; k < 16; ++k) { const int ai = k >> 3, m = (k >> 1) & 3, bj = k & 1;
            const size_t off = (size_t)(row0 + ai * HALF + m * 16) * 2048 + col0 + bj * HALF;
            const u32x4 gc = gn, yc = yn;
            if (k + 1 < 16) { const int ai2 = (k + 1) >> 3, m2 = ((k + 1) >> 1) & 3, bj2 = (k + 1) & 1; const size_t off2 = (size_t)(row0 + ai2 * HALF + m2 * 16) * 2048 + col0 + bj2 * HALF;
                gn = *(const u32x4*)(G + off2); if (MODE == 1) yn = *(const u32x4*)(Y + off2); }
            f32x4 g0, g1; unpack8v(gc, g0, g1);
            f32x4 v0 = acc[ai][bj][m][0], v1 = acc[ai][bj][m][1];
#pragma unroll
            for (int e2 = 0; e2 < 4; ++e2) { v0[e2] *= sigmoidf_(g0[e2]); v1[e2] *= sigmoidf_(g1[e2]); }
            if (MODE == 1) { f32x4 y0, y1; unpack8v(yc, y0, y1); v0 += y0; v1 += y1; }
            *(u32x4*)(Y + off) = pack8v(v0, v1); }
    }
};

__device__ __forceinline__ float dpp_ror1(float v) { return __builtin_bit_cast(float, __builtin_amdgcn_update_dpp(0, __builtin_bit_cast(int, v), 0x121, 0xf, 0xf, false)); }
__device__ __forceinline__ float dpp_ror2(float v) { return __builtin_bit_cast(float, __builtin_amdgcn_update_dpp(0, __builtin_bit_cast(int, v), 0x122, 0xf, 0xf, false)); }
typedef unsigned u32x2e __attribute__((ext_vector_type(2)));
struct EpiConvGlu {
    static constexpr bool PERM = true, AFTER_DRAIN = false;
    bf16_t* ACT; float* PART; float* TAIL; const float* cw; const float* cb;
    __device__ __forceinline__ void operator()(const f32x4 (&acc)[2][2][4][2], const Unit& u, int wr, int wc, int fr, int fq) const {
#pragma unroll
        for (int n = 0; n < 2; ++n) {
            const int ch = u.pn * 128 + wc * 32 + 8 * fq + 4 * n;
            f32x4 wg[3], wv[3];
#pragma unroll
            for (int j = 0; j < 3; ++j) { wg[j] = *(const f32x4*)(cw + j * 11264 + ch); wv[j] = *(const f32x4*)(cw + j * 11264 + 5632 + ch); }
            const f32x4 bg = *(const f32x4*)(cb + ch), bv = *(const f32x4*)(cb + 5632 + ch);
#pragma unroll
            for (int ai = 0; ai < 2; ++ai) {
                const int brow0 = u.pm * BM + ai * HALF + wr * 64, gb = brow0 >> 6;
#pragma unroll
                for (int m = 0; m < 4; ++m) {
                    f32x4 g, v;
#pragma unroll
                    for (int e = 0; e < 4; ++e) {
                        const float cg = acc[ai][0][m][n][e], cv = acc[ai][1][m][n][e];
                        float q1g = 0.f, q2g = 0.f, q1v = 0.f, q2v = 0.f;
                        if (m > 0) { const float pg = acc[ai][0][m - 1][n][e], pv = acc[ai][1][m - 1][n][e]; q1g = dpp_ror1(pg); q2g = dpp_ror2(pg); q1v = dpp_ror1(pv); q2v = dpp_ror2(pv); }
                        const float r1g = dpp_ror1(cg), r2g = dpp_ror2(cg), r1v = dpp_ror1(cv), r2v = dpp_ror2(cv);
                        const float p1g = (fr >= 1) ? r1g : q1g, p2g = (fr >= 2) ? r2g : q2g, p1v = (fr >= 1) ? r1v : q1v, p2v = (fr >= 2) ? r2v : q2v;
                        g[e] = wg[0][e] * p2g + wg[1][e] * p1g + wg[2][e] * cg + bg[e];
                        v[e] = wv[0][e] * p2v + wv[1][e] * p1v + wv[2][e] * cv + bv[e];
                    }
                    const int row = brow0 + 16 * m + fr;
                    if (m == 0 && fr < 2) {
                        float* pp = PART + (size_t)(gb * 2 + fr) * 11264 + ch;
                        *(f32x4*)pp = g; *(f32x4*)(pp + 5632) = v;
                    } else {
                        u32x2e w; w.x = pk2(siluf_(g[0]) * v[0], siluf_(g[1]) * v[1]); w.y = pk2(siluf_(g[2]) * v[2], siluf_(g[3]) * v[3]);
                        *(u32x2e*)(ACT + (size_t)row * 5632 + ch) = w;
                    }
                    if (m == 3 && fr >= 14) {
                        float* tp = TAIL + (size_t)(gb * 2 + (fr - 14)) * 11264 + ch;
                        *(f32x4*)tp = acc[ai][0][3][n]; *(f32x4*)(tp + 5632) = acc[ai][1][3][n];
                    }
                }
            }
        }
    }
};

template <class Epi, class Sched, bool ALIGN_EPI = false, bool SP2 = false>
__device__ __forceinline__ void gemm_phase(PG8_LAS unsigned char* lds, const Gemm g, const Sched& S, const Epi& E) {
    int tid_ = threadIdx.x; asm volatile("" : "+v"(tid_));
    const int tid = tid_, wid = __builtin_amdgcn_readfirstlane(tid >> 6), lane = tid & 63, wr = wid >> 2, wc = wid & 3, fr = lane & 15, fq = lane >> 4;
    const int K = g.K, nt = K / BK;
    unsigned voffA[2], voffB[2];
#pragma unroll
    for (int i = 0; i < 2; ++i) { int R, C; stage_rc(tid * 16 + i * 8192, R, C); const int Rb = Epi::PERM ? ((R & ~31) + perm32(R & 31)) : R;
        voffA[i] = (unsigned)(R * K + C) * 2u; voffB[i] = (unsigned)(Rb * K + C) * 2u; }
    const size_t kstep = (size_t)(BK * 2);
    const size_t hstep = (size_t)HALF * K * 2;
    const size_t tstep = 2 * hstep;
    const unsigned ldsw = (unsigned)wid * 1024u;
    const int aoff = lds_byte(wr * 64 + fr, fq * 8), boff = lds_byte(wc * 32 + fr, fq * 8);
#define PG8_SA(b, h) (((b) * 2 + (h)) * HTB)
#define PG8_SB(b, h) ((4 + (b) * 2 + (h)) * HTB)
#define PG8_STAGE(bufoff, gbase, voff) do { _Pragma("unroll") for (int _i = 0; _i < 2; ++_i) \
        __builtin_amdgcn_global_load_lds((const unsigned*)((const char*)(gbase) + (voff)[_i]), (PG8_LAS unsigned*)(lds + (bufoff) + ldsw + _i * 8192), 16, 0, 0); } while (0)
#define PG8_LDA(dst, b, h) do { _Pragma("unroll") for (int m = 0; m < 4; ++m) _Pragma("unroll") for (int k = 0; k < 2; ++k) dst[m][k] = *(const PG8_LAS bf16x8*)(lds + PG8_SA(b, h) + aoff + m * 2048 + k * 1024); } while (0)
#define PG8_LDB(dst, b, h) do { _Pragma("unroll") for (int n = 0; n < 2; ++n) _Pragma("unroll") for (int k = 0; k < 2; ++k) dst[n][k] = *(const PG8_LAS bf16x8*)(lds + PG8_SB(b, h) + boff + n * 2048 + k * 1024); } while (0)
#define PG8_MMA(ai, bj, At, Bt) do { __builtin_amdgcn_s_setprio(1); _Pragma("unroll") for (int m = 0; m < 4; ++m) _Pragma("unroll") for (int n = 0; n < 2; ++n) _Pragma("unroll") for (int k = 0; k < 2; ++k) \
        acc[ai][bj][m][n] = __builtin_amdgcn_mfma_f32_16x16x32_bf16(Bt[n][k], At[m][k], acc[ai][bj][m][n], 0, 0, 0); __builtin_amdgcn_s_setprio(0); } while (0)
#define PG8_WAIT_V(n) asm volatile("s_waitcnt vmcnt(" #n ")" ::: "memory")
#define PG8_WAIT_L(n) asm volatile("s_waitcnt lgkmcnt(" #n ")" ::: "memory")
#define PG8_BAR __builtin_amdgcn_s_barrier()
#define PG8_SCHED __builtin_amdgcn_sched_barrier(0)
    Unit cur, nxt; int ui = 0;
    if (!S.next(0, cur)) return;
    f32x4 acc[2][2][4][2];
#pragma unroll
    for (int a = 0; a < 2; ++a)
#pragma unroll
        for (int b = 0; b < 2; ++b)
#pragma unroll
            for (int m = 0; m < 4; ++m)
#pragma unroll
                for (int n = 0; n < 2; ++n) acc[a][b][m][n] = (f32x4){0.f, 0.f, 0.f, 0.f};
    bf16x8 At[4][2], B0[2][2], B1[2][2];
    const char* cA = (const char*)g.A + (size_t)cur.pm * tstep; const char* cB = (const char*)g.Bt + (size_t)cur.pn * tstep;
    S.a_ready(cur);
    if constexpr (SP2) {
        PG8_STAGE(PG8_SB(0, 0), cB, voffB); PG8_STAGE(PG8_SB(0, 1), cB + hstep, voffB); PG8_STAGE(PG8_SA(0, 0), cA, voffA); PG8_STAGE(PG8_SA(0, 1), cA + hstep, voffA);
        if (wr == 1) PG8_BAR;
        PG8_WAIT_V(2); PG8_BAR;
        PG8_STAGE(PG8_SB(1, 0), cB + kstep, voffB); PG8_STAGE(PG8_SA(1, 0), cA + kstep, voffA); PG8_STAGE(PG8_SB(1, 1), cB + hstep + kstep, voffB);
        PG8_WAIT_V(6); PG8_BAR;
    } else {
        PG8_STAGE(PG8_SB(0, 0), cB, voffB); PG8_STAGE(PG8_SA(0, 0), cA, voffA); PG8_STAGE(PG8_SB(0, 1), cB + hstep, voffB); PG8_STAGE(PG8_SA(0, 1), cA + hstep, voffA);
        if (wr == 1) PG8_BAR;
        PG8_WAIT_V(4); PG8_BAR;
        PG8_STAGE(PG8_SB(1, 0), cB + kstep, voffB); PG8_STAGE(PG8_SA(1, 0), cA + kstep, voffA); PG8_STAGE(PG8_SB(1, 1), cB + hstep + kstep, voffB);
        PG8_WAIT_V(6); PG8_BAR;
    }
    for (;;) {
        const bool has_next = S.next(ui + 1, nxt);
        const char* nA = has_next ? (const char*)g.A + (size_t)nxt.pm * tstep : cA; const char* nB = has_next ? (const char*)g.Bt + (size_t)nxt.pn * tstep : cB;
        for (int t = 0; t < nt; t += 2) {
            const bool last = (t == nt - 2);
            const char* a1 = cA + (size_t)(t + 1) * kstep;
            const char* a2 = last ? nA : cA + (size_t)(t + 2) * kstep; const char* b2 = last ? nB : cB + (size_t)(t + 2) * kstep;
            const char* a3 = a2 + kstep; const char* b3 = b2 + kstep;
            if (last && has_next) S.a_ready(nxt);
            if constexpr (SP2) {
            PG8_LDB(B0, 0, 0); PG8_LDB(B1, 0, 1); PG8_SCHED; PG8_LDA(At, 0, 0); PG8_STAGE(PG8_SA(1, 1), a1 + hstep, voffA);
            PG8_WAIT_V(8); PG8_WAIT_L(0); PG8_BAR; PG8_MMA(0, 0, At, B0); PG8_MMA(0, 1, At, B1); PG8_BAR; PG8_SCHED;
            PG8_LDA(At, 0, 1); PG8_STAGE(PG8_SB(0, 0), b2, voffB); PG8_STAGE(PG8_SB(0, 1), b2 + hstep, voffB); PG8_STAGE(PG8_SA(0, 0), a2, voffA);
            PG8_WAIT_V(8); PG8_WAIT_L(0); PG8_BAR; PG8_MMA(1, 0, At, B0); PG8_MMA(1, 1, At, B1); PG8_BAR; PG8_SCHED;
            PG8_LDB(B0, 1, 0); PG8_LDB(B1, 1, 1); PG8_SCHED; PG8_LDA(At, 1, 0); PG8_STAGE(PG8_SA(0, 1), a2 + hstep, voffA);
            PG8_WAIT_V(8); PG8_WAIT_L(0); PG8_BAR; PG8_MMA(0, 0, At, B0); PG8_MMA(0, 1, At, B1); PG8_BAR; PG8_SCHED;
            PG8_LDA(At, 1, 1); PG8_STAGE(PG8_SB(1, 0), b3, voffB); PG8_STAGE(PG8_SB(1, 1), b3 + hstep, voffB); PG8_STAGE(PG8_SA(1, 0), a3, voffA);
            PG8_WAIT_V(8); PG8_WAIT_L(0); PG8_BAR; PG8_MMA(1, 0, At, B0); PG8_MMA(1, 1, At, B1); PG8_BAR; PG8_SCHED;
            } else {
            PG8_LDB(B0, 0, 0); PG8_SCHED; PG8_LDA(At, 0, 0); PG8_STAGE(PG8_SA(1, 1), a1 + hstep, voffA);
            PG8_WAIT_L(8); PG8_BAR; PG8_WAIT_L(0); PG8_MMA(0, 0, At, B0); PG8_BAR; PG8_SCHED;
            PG8_LDB(B1, 0, 1); PG8_STAGE(PG8_SB(0, 0), b2, voffB);
            PG8_BAR; PG8_WAIT_L(0); PG8_MMA(0, 1, At, B1); PG8_BAR;
            PG8_LDA(At, 0, 1); PG8_STAGE(PG8_SA(0, 0), a2, voffA);
            PG8_BAR; PG8_WAIT_L(0); PG8_MMA(1, 0, At, B0); PG8_BAR; PG8_SCHED;
            PG8_STAGE(PG8_SB(0, 1), b2 + hstep, voffB);
            PG8_WAIT_V(6); PG8_BAR; PG8_MMA(1, 1, At, B1); PG8_BAR;
            PG8_LDB(B0, 1, 0); PG8_SCHED; PG8_LDA(At, 1, 0); PG8_STAGE(PG8_SA(0, 1), a2 + hstep, voffA);
            PG8_WAIT_L(8); PG8_BAR; PG8_WAIT_L(0); PG8_MMA(0, 0, At, B0); PG8_BAR; PG8_SCHED;
            PG8_LDB(B1, 1, 1); PG8_STAGE(PG8_SB(1, 0), b3, voffB);
            PG8_BAR; PG8_WAIT_L(0); PG8_MMA(0, 1, At, B1); PG8_BAR;
            PG8_LDA(At, 1, 1); PG8_STAGE(PG8_SA(1, 0), a3, voffA);
            PG8_BAR; PG8_WAIT_L(0); PG8_MMA(1, 0, At, B0); PG8_BAR; PG8_SCHED;
            PG8_STAGE(PG8_SB(1, 1), b3 + hstep, voffB);
            PG8_WAIT_V(6); PG8_BAR; PG8_MMA(1, 1, At, B1); PG8_BAR;
            }
        }
        if constexpr (ALIGN_EPI) { if (wr == 0) PG8_BAR; }
        if constexpr (!Epi::AFTER_DRAIN) { E(acc, cur, wr, wc, fr, fq); S.done(cur); }
        if (!has_next) break;
#pragma unroll
        for (int a = 0; a < 2; ++a)
#pragma unroll
            for (int b = 0; b < 2; ++b)
#pragma unroll
                for (int m = 0; m < 4; ++m)
#pragma unroll
                    for (int n = 0; n < 2; ++n) acc[a][b][m][n] = (f32x4){0.f, 0.f, 0.f, 0.f};
        cur = nxt; cA = nA; cB = nB; ++ui;
        if constexpr (ALIGN_EPI) { if (wr == 1) PG8_BAR; }
    }
    PG8_WAIT_V(0);
    if constexpr (!ALIGN_EPI) { if (wr == 0) PG8_BAR; }
    PG8_BAR;
    if constexpr (Epi::AFTER_DRAIN) { E.fused(acc, cur, wr, wc, fr, fq, lds, wid, lane); S.done(cur); }
#undef PG8_SA
#undef PG8_SB
#undef PG8_STAGE
#undef PG8_LDA
#undef PG8_LDB
#undef PG8_MMA
#undef PG8_WAIT_V
#undef PG8_WAIT_L
#undef PG8_BAR
#undef PG8_SCHED
}
}

#define LAS __attribute__((address_space(3)))
typedef unsigned short bf16_t;
typedef float f32x4 __attribute__((ext_vector_type(4)));
typedef unsigned u32x4 __attribute__((ext_vector_type(4)));
typedef unsigned u32x2 __attribute__((ext_vector_type(2)));
constexpr int NB = 8, SEQ = 4096, T = NB * SEQ, D = 2048, DEPTH = 4;
constexpr int NIN_ORIG = 15392, NIN = 15616, DFF = 5632, NUP = 2 * DFF;
constexpr int NWAVES = 8, NTHREADS = 512;
constexpr float EPS = 1e-6f;
constexpr int NPH = 12;
constexpr int NPHASES = DEPTH * NPH;

constexpr size_t MiB = 1ull << 20;
constexpr size_t WS_CTL = 0, CTL_ZERO_BYTES = 1 * MiB;
constexpr size_t WS_ROPE = 1 * MiB;
constexpr size_t WS_BA = 5 * MiB;
constexpr size_t WT_IN = 16 * MiB, WT_BA = 77 * MiB, WT_BD = 85 * MiB, WT_OUT = 93 * MiB, WT_UP = 101 * MiB, WT_DOWN = 145 * MiB;
constexpr size_t WS_XN = 168 * MiB;
constexpr size_t WS_QA = 296 * MiB;
constexpr size_t WS_KA = 424 * MiB, WS_VA = 456 * MiB;
constexpr size_t WS_QKVD = 488 * MiB;
constexpr size_t WS_ZD = 872 * MiB;
constexpr size_t WS_GA = 1000 * MiB, WS_GD = 1128 * MiB;
constexpr size_t WS_DN = 1256 * MiB;
constexpr size_t WS_HTAIL = 1640 * MiB;
constexpr size_t WS_END = 1834 * MiB;
constexpr int CW_BAR = 4096;
constexpr int CW_QUEUE = 16384;

constexpr int LDS_BYTES = 163840;
constexpr int MISC_OFF = 163840 - 256;

#define VM_WAIT() asm volatile("s_waitcnt vmcnt(0)" ::: "memory")
#define LDS_BARRIER() do { asm volatile("s_waitcnt lgkmcnt(0)" ::: "memory"); __builtin_amdgcn_s_barrier(); asm volatile("" ::: "memory"); } while (0)

#define XB_TMO      128
#define XB_XCNT(j)  (256  + 64 * (j))
#define XB_XSUB(j)  (1280 + 64 * (j))
#define XB_XGEN(j)  (2304 + 64 * (j))
#define XB_TOP      3328
#define XB_TOPGEN   3392
#define XCD_BAR_WORDS 3456
#define XB_SPIN_CAP (1u << 22)

__device__ __forceinline__ unsigned xb_ld(unsigned* p)              { return __hip_atomic_load(p, __ATOMIC_RELAXED, __HIP_MEMORY_SCOPE_AGENT); }
__device__ __forceinline__ unsigned xb_add(unsigned* p, unsigned v) { return __hip_atomic_fetch_add(p, v, __ATOMIC_RELAXED, __HIP_MEMORY_SCOPE_AGENT); }
__device__ __forceinline__ unsigned xb_xcc_id() { return (unsigned)__builtin_amdgcn_s_getreg((3 << 11) | 20) & 0xFu; }
#define XB_SPIN(cond, bar) do { unsigned _sp = 0; while (cond) { __builtin_amdgcn_s_sleep(1); \
    if ((++_sp & 255u) == 0u) { if (xb_ld(&(bar)[XB_TMO])) break; if (_sp > XB_SPIN_CAP) { atomicAdd(&(bar)[XB_TMO], 1u); break; } } } } while (0)

struct XcdBarrier {
    unsigned* bar; unsigned x;
    volatile LAS unsigned* st;
};
__device__ __forceinline__ XcdBarrier xcd_barrier_post(unsigned* bar, volatile LAS unsigned* st) {
    XcdBarrier b; b.bar = bar; b.x = xb_xcc_id(); b.st = st;
    if (threadIdx.x == 0) (void)xb_add(&bar[XB_XCNT(b.x)], 1u);
    return b;
}
__device__ __forceinline__ void xcd_barrier_complete(unsigned* bar, unsigned x, unsigned& nloc, unsigned& nx) {
    const unsigned G = gridDim.x * gridDim.y * gridDim.z;
    unsigned sum, cnt, mine, sp = 0u;
    for (;;) {
        sum = 0u; cnt = 0u; mine = 0u;
#pragma unroll
        for (unsigned j = 0; j < 16; ++j) { const unsigned c = xb_ld(&bar[XB_XCNT(j)]); sum += c; cnt += (c > 0u) ? 1u : 0u; mine = (j == x) ? c : mine; }
        if (sum == G) break;
        __builtin_amdgcn_s_sleep(1);
        if ((++sp & 255u) == 0u) { if (xb_ld(&bar[XB_TMO])) break; if (sp > XB_SPIN_CAP) { atomicAdd(&bar[XB_TMO], 1u); break; } }
    }
    nloc = mine > 0u ? mine : 1u; nx = cnt > 0u ? cnt : 1u;
}
__device__ __forceinline__ void xcd_barrier(const XcdBarrier& b) {
    asm volatile("s_waitcnt vmcnt(0)" ::: "memory");
    __syncthreads();
    if (threadIdx.x == 0) {
        unsigned* bar = b.bar;
        __builtin_amdgcn_s_waitcnt(0);
        unsigned nloc = b.st[0], nx = b.st[1];
        if (nloc == 0u) { xcd_barrier_complete(bar, b.x, nloc, nx); b.st[0] = nloc; b.st[1] = nx; }
        const unsigned old = xb_add(&bar[XB_XSUB(b.x)], 1u);
        const unsigned gen = old / nloc;
        if (old + 1u == (gen + 1u) * nloc) {
            __builtin_amdgcn_fence(__ATOMIC_RELEASE, "agent");
            asm volatile("s_waitcnt vmcnt(0)" ::: "memory");
            const unsigned og = xb_add(&bar[XB_TOP], 1u);
            const unsigned tg = og / nx;
            if (og + 1u == (tg + 1u) * nx) xb_add(&bar[XB_TOPGEN], 1u);
            else XB_SPIN(xb_ld(&bar[XB_TOPGEN]) == tg, bar);
            __builtin_amdgcn_fence(__ATOMIC_ACQUIRE, "agent");
            xb_add(&bar[XB_XGEN(b.x)], 1u);
            asm volatile("s_waitcnt vmcnt(0)" ::: "memory");
        } else {
            XB_SPIN(xb_ld(&bar[XB_XGEN(b.x)]) == gen, bar);
            __builtin_amdgcn_fence(__ATOMIC_ACQUIRE, "agent");
            asm volatile("s_waitcnt vmcnt(0)" ::: "memory");
        }
    }
    __syncthreads();
}

struct Args { const void* in[19]; float* out; unsigned char* ws; int ph_lo, ph_hi; };
struct Frame {
    LAS unsigned char* lds;
    int tid, lane, wave;
    unsigned char* ws;
    const float* x; const int* pos; float* out;
};

__device__ __forceinline__ float wave_sum(float v) {
#pragma unroll
    for (int o = 1; o < 64; o <<= 1) v += __shfl_xor(v, o);
    return v;
}
__device__ __forceinline__ float wave_max(float v) {
#pragma unroll
    for (int o = 1; o < 64; o <<= 1) v = fmaxf(v, __shfl_xor(v, o));
    return v;
}

__device__ __forceinline__ void transpose_item(const float* W, int K, int N, bf16_t* WT, LAS float* scr, int item, int lane, int remap) {
    const int nblk = N / 32, kb = item / nblk, nb = item % nblk, k0 = 64 * kb, n0 = 32 * nb;
    int n0d = n0;
    if (remap == 1) n0d = (n0 < 9216) ? n0 : ((n0 == 9216) ? 15360 : n0 - 32);
    if (remap == 2) { const int cch = (n0 < DFF) ? n0 : n0 - DFF; n0d = 256 * (cch >> 7) + ((n0 < DFF) ? 0 : 128) + (cch & 127); }
#pragma unroll 8
    for (int i = 0; i < 32; ++i) { const int kk = 2 * i + (lane >> 5); scr[kk * 33 + (lane & 31)] = W[(size_t)(k0 + kk) * N + n0 + (lane & 31)]; }
    asm volatile("s_waitcnt lgkmcnt(0)" ::: "memory");
    const int c = lane & 7;
#pragma unroll
    for (int j = 0; j < 4; ++j) { const int n = (lane >> 3) + 8 * j; const LAS float* s = scr + (8 * c) * 33 + n;
        u32x4 o; o.x = pk2(s[0 * 33], s[1 * 33]); o.y = pk2(s[2 * 33], s[3 * 33]); o.z = pk2(s[4 * 33], s[5 * 33]); o.w = pk2(s[6 * 33], s[7 * 33]);
        *(u32x4*)(WT + (size_t)(n0d + n) * K + k0 + 8 * c) = o; }
    asm volatile("s_waitcnt lgkmcnt(0)" ::: "memory");
}
__device__ __forceinline__ void ph_convert_weights(Frame& F, const __attribute__((address_space(4))) Args* a, int l) {
    LAS float* scr = (LAS float*)(F.lds + F.wave * 8448);
    const int gw = blockIdx.x * NWAVES + F.wave, NGW = gridDim.x * NWAVES;
    constexpr int I_IN = (D / 64) * (NIN_ORIG / 32), I_SQ = (D / 64) * (D / 32), I_UP = (D / 64) * (NUP / 32), I_DN = (DFF / 64) * (D / 32);
    constexpr int NITEMS = I_IN + 3 * I_SQ + I_UP + I_DN;
    const float* w_in = (const float*)a->in[3] + (size_t)l * D * NIN_ORIG;
    const float* w_ba = (const float*)a->in[9] + (size_t)l * D * D;
    const float* w_bd = (const float*)a->in[10] + (size_t)l * D * D;
    const float* w_out = (const float*)a->in[11] + (size_t)l * D * D;
    const float* w_up = (const float*)a->in[14] + (size_t)l * D * NUP;
    const float* w_dn = (const float*)a->in[17] + (size_t)l * DFF * D;
    for (int it = gw; it < NITEMS; it += NGW) {
        int r = it;
        if (r < I_IN) { transpose_item(w_in, D, NIN_ORIG, (bf16_t*)(F.ws + WT_IN), scr, r, F.lane, 1); continue; } r -= I_IN;
        if (r < I_SQ) { transpose_item(w_ba, D, D, (bf16_t*)(F.ws + WT_BA), scr, r, F.lane, 0); continue; } r -= I_SQ;
        if (r < I_SQ) { transpose_item(w_bd, D, D, (bf16_t*)(F.ws + WT_BD), scr, r, F.lane, 0); continue; } r -= I_SQ;
        if (r < I_SQ) { transpose_item(w_out, D, D, (bf16_t*)(F.ws + WT_OUT), scr, r, F.lane, 0); continue; } r -= I_SQ;
        if (r < I_UP) { transpose_item(w_up, D, NUP, (bf16_t*)(F.ws + WT_UP), scr, r, F.lane, 2); continue; } r -= I_UP;
        transpose_item(w_dn, DFF, D, (bf16_t*)(F.ws + WT_DOWN), scr, r, F.lane, 0);
    }
    { u32x4* z = (u32x4*)(F.ws + WT_IN + (size_t)NIN_ORIG * D * 2); const int n16 = (NIN - NIN_ORIG) * D * 2 / 16;
      for (int i = blockIdx.x * NTHREADS + F.tid; i < n16; i += gridDim.x * NTHREADS) z[i] = (u32x4){0u, 0u, 0u, 0u}; }
}

__device__ const float INV_FREQ[16] = {1.000000000e+00f, 4.403665960e-01f, 1.939227432e-01f, 8.539710194e-02f, 3.760603070e-02f, 1.656043902e-02f, 7.292664610e-03f, 3.211445874e-03f,
                                       1.414213562e-03f, 6.227723788e-04f, 2.742481884e-04f, 1.207697351e-04f, 5.318296098e-05f, 2.341999971e-05f, 1.031338616e-05f, 4.541670478e-06f};
__device__ __forceinline__ void ph_rope_table(Frame& F) {
    float* rope = (float*)(F.ws + WS_ROPE);
    for (int idx = blockIdx.x * NTHREADS + F.tid; idx < T * 16; idx += gridDim.x * NTHREADS) {
        const int t = idx >> 4, i = idx & 15;
        const float angf = (float)F.pos[t] * INV_FREQ[i];
        const double ang = (double)angf;
        const double TWO_PI = 6.283185307179586476925;
        const double r = ang - rint(ang / TWO_PI) * TWO_PI;
        const double r2 = r * r;
        double c = 1.0, s = r, tc = 1.0, ts = r;
#pragma unroll
        for (int k = 1; k <= 14; ++k) { tc *= -r2 / (double)((2 * k - 1) * (2 * k)); c += tc; ts *= -r2 / (double)((2 * k) * (2 * k + 1)); s += ts; }
        rope[(size_t)t * 32 + i] = (float)c; rope[(size_t)t * 32 + 16 + i] = (float)s;
    }
}

__device__ __forceinline__ void ph_norm_first(Frame& F, const float* x, const float* w, bf16_t* xn) {
    const int gw = blockIdx.x * NWAVES + F.wave, NGW = gridDim.x * NWAVES;
    for (int row = gw; row < T; row += NGW) {
        const float* xr = x + (size_t)row * D + 8 * F.lane;
        f32x4 v[4][2]; float ss = 0.f;
#pragma unroll
        for (int j = 0; j < 4; ++j) { v[j][0] = *(const f32x4*)(xr + 512 * j); v[j][1] = *(const f32x4*)(xr + 512 * j + 4);
#pragma unroll
            for (int e = 0; e < 4; ++e) ss += v[j][0][e] * v[j][0][e] + v[j][1][e] * v[j][1][e]; }
        const float rstd = 1.0f / sqrtf(wave_sum(ss) * (1.0f / D) + EPS);
#pragma unroll
        for (int j = 0; j < 4; ++j) { const f32x4 w0 = *(const f32x4*)(w + 512 * j + 8 * F.lane), w1 = *(const f32x4*)(w + 512 * j + 8 * F.lane + 4);
            const f32x4 a0 = v[j][0] * rstd * w0, a1 = v[j][1] * rstd * w1;
            u32x4 o; o.x = pk2(a0[0], a0[1]); o.y = pk2(a0[2], a0[3]); o.z = pk2(a1[0], a1[1]); o.w = pk2(a1[2], a1[3]);
            *(u32x4*)(xn + (size_t)row * D + 512 * j + 8 * F.lane) = o; }
    }
}
template <bool BB, bool OB>
__device__ __forceinline__ void ph_norm_res(Frame& F, const bf16_t* src, const float* w1, const void* basev, void* outv, const float* w2, bf16_t* xn) {
    const int gw = blockIdx.x * NWAVES + F.wave, NGW = gridDim.x * NWAVES;
    for (int row0 = gw; row0 < T; row0 += 2 * NGW) {
        u32x4 sraw[2][4]; u32x4 braw[2][4]; f32x4 bf[2][4][2];
#pragma unroll
        for (int r = 0; r < 2; ++r) { const int row = row0 + r * NGW; const bool ok = row < T; const size_t ro = (size_t)(ok ? row : row0) * D + 8 * F.lane;
#pragma unroll
            for (int j = 0; j < 4; ++j) { sraw[r][j] = *(const u32x4*)(src + ro + 512 * j);
                if (BB) braw[r][j] = *(const u32x4*)((const bf16_t*)basev + ro + 512 * j);
                else { bf[r][j][0] = *(const f32x4*)((const float*)basev + ro + 512 * j); bf[r][j][1] = *(const f32x4*)((const float*)basev + ro + 512 * j + 4); } } }
#pragma unroll
        for (int r = 0; r < 2; ++r) { const int row = row0 + r * NGW; if (row >= T) break;
            const size_t ro = (size_t)row * D + 8 * F.lane;
            f32x4 v[4][2]; float ss = 0.f;
#pragma unroll
            for (int j = 0; j < 4; ++j) { const u32x4 s = sraw[r][j];
                v[j][0][0] = bf_lo(s.x); v[j][0][1] = bf_hi(s.x); v[j][0][2] = bf_lo(s.y); v[j][0][3] = bf_hi(s.y);
                v[j][1][0] = bf_lo(s.z); v[j][1][1] = bf_hi(s.z); v[j][1][2] = bf_lo(s.w); v[j][1][3] = bf_hi(s.w);
#pragma unroll
                for (int e = 0; e < 4; ++e) ss += v[j][0][e] * v[j][0][e] + v[j][1][e] * v[j][1][e]; }
            const float rstd = __builtin_amdgcn_rsqf(wave_sum(ss) * (1.0f / D) + EPS);
            float ss2 = 0.f;
#pragma unroll
            for (int j = 0; j < 4; ++j) { const f32x4 w0 = *(const f32x4*)(w1 + 512 * j + 8 * F.lane), w1v = *(const f32x4*)(w1 + 512 * j + 8 * F.lane + 4);
                f32x4 b0, b1;
                if (BB) { const u32x4 s = braw[r][j];
                    b0[0] = bf_lo(s.x); b0[1] = bf_hi(s.x); b0[2] = bf_lo(s.y); b0[3] = bf_hi(s.y); b1[0] = bf_lo(s.z); b1[1] = bf_hi(s.z); b1[2] = bf_lo(s.w); b1[3] = bf_hi(s.w); }
                else { b0 = bf[r][j][0]; b1 = bf[r][j][1]; }
                v[j][0] = b0 + v[j][0] * rstd * w0; v[j][1] = b1 + v[j][1] * rstd * w1v;
                if (OB) { u32x4 o; o.x = pk2(v[j][0][0], v[j][0][1]); o.y = pk2(v[j][0][2], v[j][0][3]); o.z = pk2(v[j][1][0], v[j][1][1]); o.w = pk2(v[j][1][2], v[j][1][3]); *(u32x4*)((bf16_t*)outv + ro + 512 * j) = o; }
                else { *(f32x4*)((float*)outv + ro + 512 * j) = v[j][0]; *(f32x4*)((float*)outv + ro + 512 * j + 4) = v[j][1]; }
#pragma unroll
                for (int e = 0; e < 4; ++e) ss2 += v[j][0][e] * v[j][0][e] + v[j][1][e] * v[j][1][e]; }
            if (w2) {
                const float rstd2 = __builtin_amdgcn_rsqf(wave_sum(ss2) * (1.0f / D) + EPS);
#pragma unroll
                for (int j = 0; j < 4; ++j) { const f32x4 w0 = *(const f32x4*)(w2 + 512 * j + 8 * F.lane), w1v = *(const f32x4*)(w2 + 512 * j + 8 * F.lane + 4);
                    const f32x4 a0 = v[j][0] * rstd2 * w0, a1 = v[j][1] * rstd2 * w1v;
                    u32x4 o; o.x = pk2(a0[0], a0[1]); o.y = pk2(a0[2], a0[3]); o.z = pk2(a1[0], a1[1]); o.w = pk2(a1[2], a1[3]);
                    *(u32x4*)(xn + ro + 512 * j) = o; }
            }
        }
    }
}

__device__ __forceinline__ void ph_ffn_fixup(Frame& F, const float* PART, const float* TAIL, const float* cw, bf16_t* ACT) {
    constexpr int NQ = DFF / 4;
    for (int idx = blockIdx.x * NTHREADS + F.tid; idx < (T / 64) * 2 * NQ; idx += gridDim.x * NTHREADS) {
        const int q = idx % NQ, br = idx / NQ, r = br & 1, band = br >> 1, ch = 4 * q;
        f32x4 g = *(const f32x4*)(PART + (size_t)br * 11264 + ch), v = *(const f32x4*)(PART + (size_t)br * 11264 + 5632 + ch);
        if ((band & 63) != 0) {
            const float* t0 = TAIL + (size_t)((band - 1) * 2) * 11264 + ch; const float* t1 = t0 + 11264;
            const f32x4 w0g = *(const f32x4*)(cw + ch), w1g = *(const f32x4*)(cw + 11264 + ch), w0v = *(const f32x4*)(cw + 5632 + ch), w1v = *(const f32x4*)(cw + 11264 + 5632 + ch);
            const f32x4 t1g = *(const f32x4*)t1, t1v = *(const f32x4*)(t1 + 5632);
            if (r == 0) { const f32x4 t0g = *(const f32x4*)t0, t0v = *(const f32x4*)(t0 + 5632); g += w0g * t0g + w1g * t1g; v += w0v * t0v + w1v * t1v; }
            else { g += w0g * t1g; v += w0v * t1v; }
        }
        u32x2 o; o.x = pk2(siluf_(g[0]) * v[0], siluf_(g[1]) * v[1]); o.y = pk2(siluf_(g[2]) * v[2], siluf_(g[3]) * v[3]);
        *(u32x2*)(ACT + (size_t)(band * 64 + r) * DFF + ch) = o;
    }
}

typedef short bf16x8_t __attribute__((ext_vector_type(8)));
typedef short s16x4_t __attribute__((ext_vector_type(4)));
typedef float f32x16_t __attribute__((ext_vector_type(16)));
#define MFMA32(a, b, c) __builtin_amdgcn_mfma_f32_32x32x16_bf16((a), (b), (c), 0, 0, 0)
__device__ __forceinline__ s16x4_t lds_tr16(LAS unsigned char* p) { typedef short v4i16_t __attribute__((ext_vector_type(4))); return __builtin_bit_cast(s16x4_t, __builtin_amdgcn_ds_read_tr16_b64_v4i16((LAS v4i16_t*)p)); }
__device__ __forceinline__ void ph_attn(Frame& F, const bf16_t* QA, bf16_t* OA, const bf16_t* KA, const bf16_t* VA, const float* sinks, int first, int stride, int last) {
    LAS unsigned char* Ks = F.lds; LAS unsigned char* Vs = F.lds + 65536;
    const int lane = F.lane, w = F.wave, r = lane & 31, h = lane >> 5;
    const int vlane = ((4 * h + ((lane & 15) >> 2)) * 256) + (16 * ((lane >> 4) & 1) + 4 * (lane & 3)) * 2;
    for (int it = first; it < last; it += stride) {
        const int kvh = it & 3, blk = (it >> 2) & 31, b = it >> 7;
        const int t0 = b * SEQ + blk * 128;
        const int tk0 = (blk > 0) ? t0 - 128 : t0;
#pragma unroll
        for (int j = 0; j < 8; ++j) { const int cid = F.tid + 512 * j, key = cid >> 4, c16 = cid & 15;
            const int tok = (key < 128) ? tk0 + key : t0 + key - 128;
            const u32x4 kv = *(const u32x4*)(KA + (size_t)tok * 512 + kvh * 128 + c16 * 8), vv = *(const u32x4*)(VA + (size_t)tok * 512 + kvh * 128 + c16 * 8);
            *(LAS u32x4*)(Ks + key * 256 + ((c16 ^ (key & 15)) << 4)) = kv; *(LAS u32x4*)(Vs + key * 256 + c16 * 16) = vv; }
        LDS_BARRIER();
        const int hd = kvh * 4 + (w >> 1);
        const float sink = sinks[hd];
#pragma unroll 1
        for (int si = 0; si < 2; ++si) {
            const int s = 2 * (w & 1) + si;
            const bf16_t* qrow = QA + (size_t)(t0 + 32 * s + r) * 2048 + hd * 128; bf16_t* orow = OA + (size_t)(t0 + 32 * s + r) * 2048 + hd * 128;
            bf16x8_t qf[8];
#pragma unroll
            for (int ks = 0; ks < 8; ++ks) qf[ks] = *(const bf16x8_t*)(qrow + 16 * ks + 8 * h);
            f32x16_t S[5];
#pragma unroll
            for (int ct = 0; ct < 5; ++ct) { f32x16_t acc;
#pragma unroll
                for (int i = 0; i < 16; ++i) acc[i] = 0.f;
                const int key = 32 * (s + ct) + r;
#pragma unroll
                for (int ks = 0; ks < 8; ++ks) { const bf16x8_t kf = *(const LAS bf16x8_t*)(Ks + key * 256 + (((2 * ks + h) ^ (key & 15)) << 4)); acc = MFMA32(kf, qf[ks], acc); }
                S[ct] = acc; }
            const int qi = 32 * s + r;
            float mx = -__builtin_inff();
#pragma unroll
            for (int ct = 0; ct < 5; ++ct)
#pragma unroll
                for (int i = 0; i < 16; ++i) { const int c = 32 * (s + ct) + (i & 3) + 8 * (i >> 2) + 4 * h;
                    const bool valid = (c > qi) && (c <= qi + 128) && (blk > 0 || c >= 128);
                    const float v = valid ? S[ct][i] * 0.08838834764831845f : -__builtin_inff(); S[ct][i] = v; mx = fmaxf(mx, v); }
            mx = fmaxf(mx, __shfl_xor(mx, 32));
            const float m = fmaxf(mx, sink);
            float sum = 0.f;
#pragma unroll
            for (int ct = 0; ct < 5; ++ct)
#pragma unroll
                for (int i = 0; i < 16; ++i) { const float p = __expf(S[ct][i] - m); S[ct][i] = p; sum += p; }
            sum += __shfl_xor(sum, 32);
            const float inv = 1.0f / (sum + __expf(sink - m));
            f32x16_t O[4];
#pragma unroll
            for (int dt = 0; dt < 4; ++dt)
#pragma unroll
                for (int i = 0; i < 16; ++i) O[dt][i] = 0.f;
#pragma unroll
            for (int ct = 0; ct < 5; ++ct)
#pragma unroll
                for (int s2 = 0; s2 < 2; ++s2) {
                    u32x4 pw; pw.x = pk2(S[ct][8 * s2 + 0], S[ct][8 * s2 + 1]); pw.y = pk2(S[ct][8 * s2 + 2], S[ct][8 * s2 + 3]); pw.z = pk2(S[ct][8 * s2 + 4], S[ct][8 * s2 + 5]); pw.w = pk2(S[ct][8 * s2 + 6], S[ct][8 * s2 + 7]);
                    const bf16x8_t pf = __builtin_bit_cast(bf16x8_t, pw);
                    LAS unsigned char* vb = Vs + vlane + (32 * (s + ct) + 16 * s2) * 256;
#pragma unroll
                    for (int dt = 0; dt < 4; ++dt) { const s16x4_t va = lds_tr16(vb + dt * 64), vc = lds_tr16(vb + dt * 64 + 2048);
                        const bf16x8_t vf = __builtin_shufflevector(va, vc, 0, 1, 2, 3, 4, 5, 6, 7);
                        O[dt] = MFMA32(vf, pf, O[dt]); }
                }
#pragma unroll
            for (int dt = 0; dt < 4; ++dt)
#pragma unroll
                for (int gq = 0; gq < 4; ++gq) { u32x2 o; o.x = pk2(O[dt][4 * gq] * inv, O[dt][4 * gq + 1] * inv); o.y = pk2(O[dt][4 * gq + 2] * inv, O[dt][4 * gq + 3] * inv);
                    *(u32x2*)(orow + 32 * dt + 8 * gq + 4 * h) = o; }
        }
        LDS_BARRIER();
    }
}

#ifndef DUP_S1
#define DUP_S1 1
#endif
#ifndef DUP_S2
#define DUP_S2 1
#endif
#ifndef DUP_S3
#define DUP_S3 1
#endif
#ifndef DUP_S5
#define DUP_S5 1
#endif
#ifndef DUP_SOLVE
#define DUP_SOLVE 0
#endif
constexpr int DR_W = 0, DR_QG = 16384, DR_KG = 32768, DR_QK = 49152, DR_DL = 55296, DR_U = 55552, DR_BYTES = 72192;
#ifndef SCAN_AUX
#define SCAN_AUX 0
#endif
constexpr int DN_LBUF = 57344;
#define MFMA16(a, b, c) __builtin_amdgcn_mfma_f32_16x16x32_bf16((a), (b), (c), 0, 0, 0)
__device__ __forceinline__ int tsw(int row, int col) { return row * 272 + col * 2; }
__device__ __forceinline__ bf16_t bf16r(float v) { return (bf16_t)(pk2(v, 0.f) & 0xffffu); }
__device__ __forceinline__ void unpack8(const u32x4 w, float* o) { o[0] = bf_lo(w.x); o[1] = bf_hi(w.x); o[2] = bf_lo(w.y); o[3] = bf_hi(w.y); o[4] = bf_lo(w.z); o[5] = bf_hi(w.z); o[6] = bf_lo(w.w); o[7] = bf_hi(w.w); }
__device__ __forceinline__ bf16x8_t packstep(const f32x16_t& X, const int s) { u32x4 p; p.x = pk2(X[8 * s], X[8 * s + 1]); p.y = pk2(X[8 * s + 2], X[8 * s + 3]); p.z = pk2(X[8 * s + 4], X[8 * s + 5]); p.w = pk2(X[8 * s + 6], X[8 * s + 7]); return __builtin_bit_cast(bf16x8_t, p); }

__device__ __forceinline__ bf16x8_t mk_b(const f32x4 p, const f32x4 q) { u32x4 w; w.x = pk2(p[0], p[1]); w.y = pk2(p[2], p[3]); w.z = pk2(q[0], q[1]); w.w = pk2(q[2], q[3]); return __builtin_bit_cast(bf16x8_t, w); }
__device__ __forceinline__ bf16x8_t mk_a(const u32x2 p, const u32x2 q) { u32x4 w; w.x = p.x; w.y = p.y; w.z = q.x; w.w = q.y; return __builtin_bit_cast(bf16x8_t, w); }
__device__ __forceinline__ void ph_dn_prep(Frame& F, const bf16_t* QKVD, const float* BAf, const float* convw, const float* a_log, const float* dt_bias, unsigned char* DN) {
    const int hb = F.tid >> 8, lw = (F.tid >> 6) & 3, lane = F.lane;
    int ltid = F.tid & 255;
#define DN_LAUNDER() asm volatile("" : "+v"(ltid))
    LAS unsigned char* HB = F.lds + hb * 75776;
    LAS unsigned char* QH = HB; LAS unsigned char* KH = HB + 17408; LAS unsigned char* VH = HB + 34816;
    LAS float* AD = (LAS float*)(HB + 52224);
    LAS unsigned char* ABF = HB + 56320;
    LAS unsigned char* QKS = HB + 64512;
    LAS unsigned char* TIB = HB + 72704;
    LAS float* SC = (LAS float*)(HB + 74752);
    volatile LAS unsigned* hcnt = (volatile LAS unsigned*)(F.lds + MISC_OFF + 64 + 64 * hb);
    if (ltid == 0) *hcnt = 0u;
    LDS_BARRIER();
#define HALF_BARRIER() do { asm volatile("s_waitcnt lgkmcnt(0)" ::: "memory"); unsigned old_ = 0u; \
        if (lane == 0) old_ = __hip_atomic_fetch_add((LAS unsigned*)hcnt, 1u, __ATOMIC_RELAXED, __HIP_MEMORY_SCOPE_WORKGROUP); \
        const unsigned tgt_ = ((unsigned)__builtin_amdgcn_readfirstlane((int)old_) & ~3u) + 4u; unsigned sp_ = 0u; \
        while ((unsigned)__builtin_amdgcn_readfirstlane((int)*hcnt) < tgt_) { __builtin_amdgcn_s_sleep(1); if (++sp_ > (1u << 22)) break; } \
        asm volatile("" ::: "memory"); } while (0)
    u32x4 xr[3][7];
#define DN_LOADRAW(IT) do { const int hp_ = (IT) & 7, cidx_ = (IT) >> 3, h_ = 2 * hp_ + hb, n_ = cidx_ & 63; const int cg_ = ltid & 15, rs_ = ltid >> 4; \
        _Pragma("unroll") for (int sec_ = 0; sec_ < 3; ++sec_) { const int col_ = sec_ * 2048 + h_ * 128 + 8 * cg_; \
            _Pragma("unroll") for (int k_ = 0; k_ < 7; ++k_) { const int rloc_ = 4 * rs_ - 3 + k_; \
                if (n_ * 64 + rloc_ >= 0) xr[sec_][k_] = *(const u32x4*)(QKVD + (size_t)(cidx_ * 64 + rloc_) * 6144 + col_); else xr[sec_][k_] = (u32x4){0u, 0u, 0u, 0u}; } } } while (0)
    for (int it = blockIdx.x; it < NB * 64 * 8; it += gridDim.x) {
        const int hp = it & 7, cidx = it >> 3, h = 2 * hp + hb, b = cidx >> 6, n = cidx & 63;
        const int tb = cidx * 64;
        unsigned char* rec = DN + (size_t)((b * 16 + h) * 64 + n) * DR_BYTES;
        DN_LAUNDER();
        DN_LOADRAW(it);
        { const int cg = ltid & 15, rs = ltid >> 4;
#pragma unroll
          for (int sec = 0; sec < 3; ++sec) {
              const int col = sec * 2048 + h * 128 + 8 * cg;
              float wv[4][8];
#pragma unroll
              for (int j = 0; j < 4; ++j) { const f32x4 a0 = *(const f32x4*)(convw + j * 6144 + col), a1 = *(const f32x4*)(convw + j * 6144 + col + 4);
#pragma unroll
                  for (int e = 0; e < 4; ++e) { wv[j][e] = a0[e]; wv[j][4 + e] = a1[e]; } }
              LAS unsigned char* tile = (sec == 0) ? QH : ((sec == 1) ? KH : VH);
#pragma unroll
              for (int rr = 0; rr < 4; ++rr) { float o[8]; float ss = 0.f; float x0[8], x1[8], x2[8], x3[8]; unpack8(xr[sec][rr], x0); unpack8(xr[sec][rr + 1], x1); unpack8(xr[sec][rr + 2], x2); unpack8(xr[sec][rr + 3], x3);
#pragma unroll
                  for (int e = 0; e < 8; ++e) { const float a = wv[0][e] * x0[e] + wv[1][e] * x1[e] + wv[2][e] * x2[e] + wv[3][e] * x3[e]; o[e] = siluf_(a); ss += o[e] * o[e]; }
                  if (sec < 2) { ss += __shfl_xor(ss, 1); ss += __shfl_xor(ss, 2); ss += __shfl_xor(ss, 4); ss += __shfl_xor(ss, 8);
                      const float sc = __builtin_amdgcn_rsqf(ss + 1e-6f) * ((sec == 0) ? 0.08838834764831845f : 1.0f);
#pragma unroll
                      for (int e = 0; e < 8; ++e) o[e] *= sc; }
                  u32x4 pw; pw.x = pk2(o[0], o[1]); pw.y = pk2(o[2], o[3]); pw.z = pk2(o[4], o[5]); pw.w = pk2(o[6], o[7]);
                  *(LAS u32x4*)(tile + tsw(4 * rs + rr, 8 * cg)) = pw; }
              __builtin_amdgcn_sched_barrier(0);
          } }
        if (lw == 0) { const int i = lane; const size_t tok = (size_t)tb + i;
            const float bd = BAf[tok * 32 + h], ad = BAf[tok * 32 + 16 + h];
            const float xs = ad + dt_bias[h]; const float sp = (xs > 20.f) ? xs : log1pf(__expf(xs));
            float gc = -__expf(a_log[h]) * sp;
            int ln = lane; asm volatile("" : "+v"(ln));
#pragma unroll
            for (int o = 1; o < 64; o <<= 1) { const int src = (ln >= o) ? ln - o : ln; const float t = __builtin_bit_cast(float, __builtin_amdgcn_ds_bpermute(src << 2, __builtin_bit_cast(int, gc))); if (ln >= o) gc += t; }
            const float gl = __builtin_bit_cast(float, __builtin_amdgcn_readlane(__builtin_bit_cast(int, gc), 63));
            SC[i] = sigmoidf_(bd); SC[64 + i] = gc; SC[128 + i] = __expf(gc); SC[192 + i] = __expf(gl - gc);
            if (lane == 0) *(float*)(rec + DR_DL) = __expf(gl); }
        HALF_BARRIER();
        { const int I = lw, fr = lane & 15, fq = lane >> 4;
          bf16x8_t ak[4], aq[4];
#pragma unroll
          for (int ks = 0; ks < 4; ++ks) { ak[ks] = *(const LAS bf16x8_t*)(KH + tsw(16 * I + fr, 32 * ks + 8 * fq)); aq[ks] = *(const LAS bf16x8_t*)(QH + tsw(16 * I + fr, 32 * ks + 8 * fq)); }
          float gci[4], bti[4];
#pragma unroll
          for (int q = 0; q < 4; ++q) { gci[q] = SC[64 + 16 * I + 4 * fq + q]; bti[q] = SC[16 * I + 4 * fq + q]; }
#pragma unroll
          for (int J = 0; J < 4; ++J) { f32x4 ckk = {0.f, 0.f, 0.f, 0.f}, cqk = ckk;
#pragma unroll
              for (int ks = 0; ks < 4; ++ks) { const bf16x8_t bfr = *(const LAS bf16x8_t*)(KH + tsw(16 * J + fr, 32 * ks + 8 * fq)); ckk = MFMA16(ak[ks], bfr, ckk); cqk = MFMA16(aq[ks], bfr, cqk); }
              const int j = 16 * J + fr; const float gcj = SC[64 + j];
#pragma unroll
              for (int q = 0; q < 4; ++q) { const int i = 16 * I + 4 * fq + q; const float ex = __expf(fminf(gci[q] - gcj, 0.f));
                  const float av = (j < i) ? bti[q] * ckk[q] * ex : 0.f;
                  *(LAS bf16_t*)(ABF + (i * 64 + j) * 2) = bf16r(-av);
                  if (J == I) AD[I * 256 + (4 * fq + q) * 16 + fr] = av;
                  *(LAS bf16_t*)(QKS + (i * 64 + j) * 2) = bf16r((j <= i) ? cqk[q] * ex : 0.f); } } }
        HALF_BARRIER();
        DN_LAUNDER();
#pragma unroll
        for (int q4 = 0; q4 < 4; ++q4) { const int p = ltid + 256 * q4, mk = p >> 6, lp = p & 63, hh = lp >> 5, rr = lp & 31, mt = mk >> 3, ks = mk & 7, row = 32 * mt + rr;
            const u32x2 a = *(const LAS u32x2*)(QH + tsw(row, 16 * ks + 4 * hh)), b2 = *(const LAS u32x2*)(QH + tsw(row, 16 * ks + 8 + 4 * hh));
            const float sc = SC[128 + row];
            u32x4 o; o.x = pk2(bf_lo(a.x) * sc, bf_hi(a.x) * sc); o.y = pk2(bf_lo(a.y) * sc, bf_hi(a.y) * sc); o.z = pk2(bf_lo(b2.x) * sc, bf_hi(b2.x) * sc); o.w = pk2(bf_lo(b2.y) * sc, bf_hi(b2.y) * sc);
            __builtin_nontemporal_store(o, (u32x4*)(rec + DR_QG + p * 16)); }
#pragma unroll
        for (int q4 = 0; q4 < 4; ++q4) { const int p = ltid + 256 * q4, mk = p >> 6, lp = p & 63, hh = lp >> 5, rr = lp & 31, mt = mk >> 2, ks = mk & 3, d = 32 * mt + rr;
            float v[8];
#pragma unroll
            for (int j = 0; j < 8; ++j) { const int cc = 16 * ks + 8 * (j >> 2) + 4 * hh + (j & 3); v[j] = bf1(*(const LAS bf16_t*)(KH + tsw(cc, d))) * SC[192 + cc]; }
            u32x4 o; o.x = pk2(v[0], v[1]); o.y = pk2(v[2], v[3]); o.z = pk2(v[4], v[5]); o.w = pk2(v[6], v[7]);
            __builtin_nontemporal_store(o, (u32x4*)(rec + DR_KG + p * 16)); }
#pragma unroll
        for (int q2 = 0; q2 < 2; ++q2) { const int p = ltid + 256 * q2, mk = p >> 6, lp = p & 63, hh = lp >> 5, rr = lp & 31, mt = mk >> 2, ks = mk & 3, i = 32 * mt + rr;
            if (mt == 0 && ks >= 2) continue;
            const u32x2 a = *(const LAS u32x2*)(QKS + (i * 64 + 16 * ks + 4 * hh) * 2), b2 = *(const LAS u32x2*)(QKS + (i * 64 + 16 * ks + 8 + 4 * hh) * 2);
            u32x4 o; o.x = a.x; o.y = a.y; o.z = b2.x; o.w = b2.y;
            __builtin_nontemporal_store(o, (u32x4*)(rec + DR_QK + ((mt == 0 ? ks : 2 + ks) * 64 + lp) * 16)); }
        if (lw == 0) { const int I = lane >> 4, cc = lane & 15; const LAS float* ad = AD + I * 256;
            float t[16];
#pragma unroll
            for (int i = 0; i < 16; ++i) { float s = 0.f;
#pragma unroll
                for (int j = 0; j < i; ++j) s += ad[i * 16 + j] * t[j];
                t[i] = ((i == cc) ? 1.f : 0.f) - s; }
#pragma unroll
            for (int m = 0; m < 16; ++m) *(LAS bf16_t*)(TIB + ((I * 16 + m) * 16 + cc) * 2) = bf16r(t[m]); }
        HALF_BARRIER();
        DN_LAUNDER();
        { const int fr = lane & 15, fq = lane >> 4;
          const u32x2 z2 = {0u, 0u}; const f32x4 z4 = {0.f, 0.f, 0.f, 0.f};
          bf16x8_t aT[4], a10, a2x, a3x, a32;
#pragma unroll
          for (int I = 0; I < 4; ++I) aT[I] = mk_a(*(const LAS u32x2*)(TIB + ((I * 16 + fr) * 16 + 4 * fq) * 2), z2);
          a10 = mk_a(*(const LAS u32x2*)(ABF + ((16 + fr) * 64 + 4 * fq) * 2), z2);
          a2x = mk_a(*(const LAS u32x2*)(ABF + ((32 + fr) * 64 + 4 * fq) * 2), *(const LAS u32x2*)(ABF + ((32 + fr) * 64 + 16 + 4 * fq) * 2));
          a3x = mk_a(*(const LAS u32x2*)(ABF + ((48 + fr) * 64 + 4 * fq) * 2), *(const LAS u32x2*)(ABF + ((48 + fr) * 64 + 16 + 4 * fq) * 2));
          a32 = mk_a(*(const LAS u32x2*)(ABF + ((48 + fr) * 64 + 32 + 4 * fq) * 2), z2);
          float bt[4][4], eg[4][4];
#pragma unroll
          for (int I = 0; I < 4; ++I)
#pragma unroll
              for (int q = 0; q < 4; ++q) { bt[I][q] = SC[16 * I + 4 * fq + q]; eg[I][q] = SC[128 + 16 * I + 4 * fq + q]; }
#pragma unroll 1
          for (int pass = 0; pass < 2; ++pass) {
#pragma unroll
              for (int tt = 0; tt < 2; ++tt) { const int col = 16 * (2 * lw + tt) + fr;
                  f32x4 R[4];
#pragma unroll
                  for (int I = 0; I < 4; ++I)
#pragma unroll
                      for (int q = 0; q < 4; ++q) { const int row = 16 * I + 4 * fq + q;
                          R[I][q] = (pass == 0) ? -bf1(*(const LAS bf16_t*)(KH + tsw(row, col))) * bt[I][q] * eg[I][q] : bf1(*(const LAS bf16_t*)(VH + tsw(row, col))) * bt[I][q]; }
                  const f32x4 X0 = MFMA16(aT[0], mk_b(R[0], z4), z4);
                  const f32x4 E1 = MFMA16(a10, mk_b(X0, z4), R[1]);
                  const f32x4 X1 = MFMA16(aT[1], mk_b(E1, z4), z4);
                  const f32x4 E2 = MFMA16(a2x, mk_b(X0, X1), R[2]);
                  const f32x4 X2 = MFMA16(aT[2], mk_b(E2, z4), z4);
                  f32x4 E3 = MFMA16(a3x, mk_b(X0, X1), R[3]);
                  E3 = MFMA16(a32, mk_b(X2, z4), E3);
                  const f32x4 X3 = MFMA16(aT[3], mk_b(E3, z4), z4);
                  if (pass == 0) {
#pragma unroll
                      for (int q = 0; q < 4; ++q) { *(LAS bf16_t*)(QH + tsw(4 * fq + q, col)) = bf16r(X0[q]); *(LAS bf16_t*)(QH + tsw(16 + 4 * fq + q, col)) = bf16r(X1[q]);
                          *(LAS bf16_t*)(QH + tsw(32 + 4 * fq + q, col)) = bf16r(X2[q]); *(LAS bf16_t*)(QH + tsw(48 + 4 * fq + q, col)) = bf16r(X3[q]); }
                  } else {
                      u32x2 o; o.x = pk2(X0[0], X0[1]); o.y = pk2(X0[2], X0[3]); *(LAS u32x2*)(KH + col * 128 + (4 * fq) * 2) = o;
                      o.x = pk2(X1[0], X1[1]); o.y = pk2(X1[2], X1[3]); *(LAS u32x2*)(KH + col * 128 + (16 + 4 * fq) * 2) = o;
                      o.x = pk2(X2[0], X2[1]); o.y = pk2(X2[2], X2[3]); *(LAS u32x2*)(KH + col * 128 + (32 + 4 * fq) * 2) = o;
                      o.x = pk2(X3[0], X3[1]); o.y = pk2(X3[2], X3[3]); *(LAS u32x2*)(KH + col * 128 + (48 + 4 * fq) * 2) = o; }
              }
              if (pass == 0) HALF_BARRIER();
          } }
        HALF_BARRIER();
        DN_LAUNDER();
#pragma unroll
        for (int q4 = 0; q4 < 4; ++q4) { const int p = ltid + 256 * q4, mk = p >> 6, lp = p & 63, hh = lp >> 5, rr = lp & 31, mt = mk >> 3, ks = mk & 7, row = 32 * mt + rr;
            const u32x2 a = *(const LAS u32x2*)(QH + tsw(row, 16 * ks + 4 * hh)), b2 = *(const LAS u32x2*)(QH + tsw(row, 16 * ks + 8 + 4 * hh));
            u32x4 o; o.x = a.x; o.y = a.y; o.z = b2.x; o.w = b2.y;
            __builtin_nontemporal_store(o, (u32x4*)(rec + DR_W + p * 16)); }
#pragma unroll
        for (int q2 = 0; q2 < 2; ++q2) { const int p = ltid + 256 * q2, mk = p >> 6, lp = p & 63, hh = lp >> 5, rr = lp & 31, ct = mk >> 2, et = mk & 3, e = 32 * et + rr;
            u32x2 g[4];
#pragma unroll
            for (int gq = 0; gq < 4; ++gq) g[gq] = *(const LAS u32x2*)(KH + e * 128 + (32 * ct + 8 * gq + 4 * hh) * 2);
            u32x4 o0, o1; o0.x = g[0].x; o0.y = g[0].y; o0.z = g[1].x; o0.w = g[1].y; o1.x = g[2].x; o1.y = g[2].y; o1.z = g[3].x; o1.w = g[3].y;
            __builtin_nontemporal_store(o0, (u32x4*)(rec + DR_U + p * 32)); __builtin_nontemporal_store(o1, (u32x4*)(rec + DR_U + p * 32 + 16)); }
        HALF_BARRIER();
    }
    LDS_BARRIER();
#undef DN_LAUNDER
#undef HALF_BARRIER
#undef DN_LOADRAW
}

__device__ __forceinline__ void dn_epilogue(int t2, LAS unsigned char* Ob  , const u32x4 (&zr)[4], const LAS float* nwl  , bf16_t* OD, int tok0, int h) {
    const int c = t2 >> 2, cq = t2 & 3;
    float ss = 0.f;
#pragma unroll
    for (int k = 0; k < 4; ++k) { float t[8]; unpack8(*(const LAS u32x4*)(Ob + (c * 128 + 32 * cq + 8 * k) * 2), t);
#pragma unroll
        for (int e = 0; e < 8; ++e) ss += t[e] * t[e]; }
    asm volatile("" ::: "memory");
    ss += __shfl_xor(ss, 1); ss += __shfl_xor(ss, 2);
    const float rstd = __builtin_amdgcn_rsqf(ss * (1.0f / 128.f) + EPS);
    bf16_t* op = OD + (size_t)(tok0 + c) * 2048 + h * 128 + 32 * cq;
#pragma unroll
    for (int k2 = 0; k2 < 4; ++k2) { float z[8], ov[8]; unpack8(zr[k2], z); unpack8(*(const LAS u32x4*)(Ob + (c * 128 + 32 * cq + 8 * k2) * 2), ov);
        float y[8];
        const f32x4 n0 = *(const LAS f32x4*)(nwl + 32 * cq + 8 * k2), n1 = *(const LAS f32x4*)(nwl + 32 * cq + 8 * k2 + 4);
#pragma unroll
        for (int e = 0; e < 4; ++e) { y[e] = ov[e] * rstd * n0[e] * siluf_(z[e]); y[4 + e] = ov[4 + e] * rstd * n1[e] * siluf_(z[4 + e]); }
        u32x4 o; o.x = pk2(y[0], y[1]); o.y = pk2(y[2], y[3]); o.z = pk2(y[4], y[5]); o.w = pk2(y[6], y[7]);
        *(u32x4*)(op + 8 * k2) = o; }
}
__device__ __forceinline__ void ph_dn_scan(Frame& F, int it, const bf16_t* ZD, bf16_t* OD, const float* norm_w, const unsigned char* DN) {
    const int b = it >> 4, h = it & 15, lane = F.lane, w = F.wave;
    const unsigned char* recs = DN + (size_t)((b * 16 + h) * 64) * DR_BYTES;
    const __amdgpu_buffer_rsrc_t rsrc = __builtin_amdgcn_make_buffer_rsrc((void*)recs, 0, 64 * DR_BYTES, 0x00020000);
#define BLD16(voff, soff) __builtin_bit_cast(u32x4, __builtin_amdgcn_raw_buffer_load_b128(rsrc, (voff), (soff), SCAN_AUX))
    LAS unsigned char* Ob = F.lds + 2 * DN_LBUF;
    if (w < 4) {
        f32x16_t S[4];
#pragma unroll
        for (int dt = 0; dt < 4; ++dt)
#pragma unroll
            for (int i = 0; i < 16; ++i) S[dt][i] = 0.f;
        u32x4 uA[2][2], uB[2][2];
#pragma unroll
        for (int ct = 0; ct < 2; ++ct) { uA[ct][0] = BLD16(lane * 32, DR_U + (ct * 4 + w) * 2048); uA[ct][1] = BLD16(lane * 32 + 16, DR_U + (ct * 4 + w) * 2048);
            uB[ct][0] = BLD16(lane * 32, DR_BYTES + DR_U + (ct * 4 + w) * 2048); uB[ct][1] = BLD16(lane * 32 + 16, DR_BYTES + DR_U + (ct * 4 + w) * 2048); }
        LDS_BARRIER();
#define SC_CHUNK(n, UU) do { \
            int lv = lane; asm volatile("" : "+v"(lv));     \
            LAS unsigned char* buf = F.lds + ((n) & 1) * DN_LBUF; \
            const float dl = *(const LAS float*)(buf + DR_DL); \
            f32x16_t v[2], o[2]; \
            _Pragma("unroll") for (int ct = 0; ct < 2; ++ct) { float t0[8], t1[8]; unpack8(UU[ct][0], t0); unpack8(UU[ct][1], t1); \
                _Pragma("unroll") for (int i = 0; i < 8; ++i) { v[ct][i] = t0[i]; v[ct][8 + i] = t1[i]; o[ct][i] = 0.f; o[ct][8 + i] = 0.f; } } \
            if ((n) + 2 < 64) {                              \
                _Pragma("unroll") for (int ct = 0; ct < 2; ++ct) { UU[ct][0] = BLD16(lv * 32, ((n) + 2) * DR_BYTES + DR_U + (ct * 4 + w) * 2048); UU[ct][1] = BLD16(lv * 32 + 16, ((n) + 2) * DR_BYTES + DR_U + (ct * 4 + w) * 2048); } } \
              \
            bf16x8_t fa[2][4], fb[2][3]; \
            SC_LDA(0); \
            _Pragma("unroll") for (int ks = 0; ks < 8; ++ks) {                 \
                if (ks + 1 < 8) SC_LDA(ks + 1); else SC_LDB(0, 0); \
                __builtin_amdgcn_sched_barrier(0); \
                const bf16x8_t sp = packstep(S[ks >> 1], ks & 1); \
                _Pragma("unroll") for (int ct = 0; ct < 2; ++ct) { v[ct] = MFMA32(fa[ks & 1][2 * ct], sp, v[ct]); o[ct] = MFMA32(fa[ks & 1][2 * ct + 1], sp, o[ct]); } \
                __builtin_amdgcn_sched_barrier(0); } \
            _Pragma("unroll") for (int dt = 0; dt < 4; ++dt) _Pragma("unroll") for (int i = 0; i < 16; ++i) S[dt][i] *= dl; \
            _Pragma("unroll") for (int k2 = 0; k2 < 4; ++k2) {                 \
                const bf16x8_t vp = packstep(v[k2 >> 1], k2 & 1); \
                SC_LDB(k2, 1); \
                __builtin_amdgcn_sched_barrier(0); \
                if (k2 < 2) o[0] = MFMA32(fb[0][0], vp, o[0]);                \
                o[1] = MFMA32(fb[0][1], vp, o[1]); S[0] = MFMA32(fb[0][2], vp, S[0]); \
                __builtin_amdgcn_sched_barrier(0); \
                if (k2 + 1 < 4) SC_LDB(k2 + 1, 0); \
                __builtin_amdgcn_sched_barrier(0); \
                S[1] = MFMA32(fb[1][0], vp, S[1]); S[2] = MFMA32(fb[1][1], vp, S[2]); S[3] = MFMA32(fb[1][2], vp, S[3]); \
                __builtin_amdgcn_sched_barrier(0); } \
            { LAS unsigned char* ob = Ob + ((n) & 1) * 16384; \
              _Pragma("unroll") for (int ct = 0; ct < 2; ++ct) _Pragma("unroll") for (int i = 0; i < 16; ++i) \
                  *(LAS bf16_t*)(ob + ((32 * ct + (i & 3) + 8 * (i >> 2) + 4 * (lv >> 5)) * 128 + 32 * w + (lv & 31)) * 2) = bf16r(o[ct][i]); } \
            LDS_BARRIER();                                  \
        } while (0)
#define SC_LDA(ks) do { _Pragma("unroll") for (int ct_ = 0; ct_ < 2; ++ct_) { fa[(ks) & 1][2 * ct_] = *(const LAS bf16x8_t*)(buf + DR_W + ((ct_ * 8 + (ks)) * 64 + lv) * 16); fa[(ks) & 1][2 * ct_ + 1] = *(const LAS bf16x8_t*)(buf + DR_QG + ((ct_ * 8 + (ks)) * 64 + lv) * 16); } } while (0)
#define SC_LDB(k2, hf) do { if ((hf) == 0) { if ((k2) < 2) fb[0][0] = *(const LAS bf16x8_t*)(buf + DR_QK + ((k2) * 64 + lv) * 16); fb[0][1] = *(const LAS bf16x8_t*)(buf + DR_QK + ((2 + (k2)) * 64 + lv) * 16); \
                fb[0][2] = *(const LAS bf16x8_t*)(buf + DR_KG + ((0 * 4 + (k2)) * 64 + lv) * 16); } \
            else { _Pragma("unroll") for (int dt_ = 1; dt_ < 4; ++dt_) fb[1][dt_ - 1] = *(const LAS bf16x8_t*)(buf + DR_KG + ((dt_ * 4 + (k2)) * 64 + lv) * 16); } } while (0)
#pragma unroll 1
        for (int n = 0; n < 64; n += 2) { SC_CHUNK(n, uA); SC_CHUNK(n + 1, uB); }
#undef SC_CHUNK
#undef SC_LDA
#undef SC_LDB
        LDS_BARRIER();
    } else {
        const int t2 = F.tid - 256, sg = t2 >> 7, tg = t2 & 127;
        u32x4 stg[28];
        if (sg == 0) {
#pragma unroll
            for (int k = 0; k < 28; ++k) stg[k] = BLD16(tg * 16, 2048 * k);
#pragma unroll
            for (int k = 0; k < 28; ++k) *(LAS u32x4*)(F.lds + (tg + 128 * k) * 16) = stg[k];
            asm volatile("s_waitcnt lgkmcnt(0)" ::: "memory"); __builtin_amdgcn_sched_barrier(0);
#pragma unroll
            for (int k = 0; k < 28; ++k) stg[k] = BLD16(tg * 16, 2 * DR_BYTES + 2048 * k);
        } else {
#pragma unroll
            for (int k = 0; k < 28; ++k) stg[k] = BLD16(tg * 16, DR_BYTES + 2048 * k);
        }
        LAS float* nwl = (LAS float*)(F.lds + 2 * DN_LBUF + 32768);
        if (t2 < 32) *(LAS f32x4*)(nwl + 4 * t2) = *(const f32x4*)(norm_w + 4 * t2);
        LDS_BARRIER();
#define SC_STAGE(n, GRP) do { \
            int t2v = t2; asm volatile("" : "+v"(t2v));     \
            u32x4 zr[4];                                     \
            { const bf16_t* zp_ = ZD + (size_t)(b * SEQ + ((n) > 0 ? (n) - 1 : 0) * 64 + (t2v >> 2)) * 2048 + h * 128 + 32 * (t2v & 3); \
              _Pragma("unroll") for (int k = 0; k < 4; ++k) zr[k] = *(const u32x4*)(zp_ + 8 * k); } \
            if (sg == (GRP)) {                               \
                if ((n) + 1 < 64) { LAS unsigned char* nb = F.lds + (((n) + 1) & 1) * DN_LBUF; \
                    _Pragma("unroll") for (int k = 0; k < 28; ++k) *(LAS u32x4*)(nb + (tg + 128 * k) * 16) = stg[k]; } \
                if ((n) + 3 < 64) { \
                    _Pragma("unroll") for (int k = 0; k < 28; ++k) stg[k] = BLD16(tg * 16, ((n) + 3) * DR_BYTES + 2048 * k); } } \
            if ((n) > 0) dn_epilogue(t2v, Ob + (((n) - 1) & 1) * 16384, zr, nwl, OD, b * SEQ + ((n) - 1) * 64, h); \
            LDS_BARRIER();                                   \
        } while (0)
#pragma unroll 1
        for (int n = 0; n < 64; n += 2) { SC_STAGE(n, 1); SC_STAGE(n + 1, 0); }
#undef SC_STAGE
        { u32x4 zr[4]; const bf16_t* zp_ = ZD + (size_t)(b * SEQ + 63 * 64 + (t2 >> 2)) * 2048 + h * 128 + 32 * (t2 & 3);
#pragma unroll
          for (int k = 0; k < 4; ++k) zr[k] = *(const u32x4*)(zp_ + 8 * k);
          dn_epilogue(t2, Ob + 16384, zr, nwl, OD, b * SEQ + 63 * 64, h); }
        LDS_BARRIER();
    }
#undef BLD16
}

#ifdef MK_ATTN_TAIL
#define MK_ATTN_LAST nfirst
#else
#define MK_ATTN_LAST natt
#endif
#ifndef REP_SCAN
#define REP_SCAN 1
#endif
#ifndef REP_ATTN
#define REP_ATTN 1
#endif
#ifndef REP_P0
#define REP_P0 1
#endif
#ifndef REP_P1
#define REP_P1 1
#endif
#ifndef REP_P2
#define REP_P2 1
#endif
#ifndef REP_P4
#define REP_P4 1
#endif
#ifndef REP_P6
#define REP_P6 1
#endif
#ifndef REP_P8
#define REP_P8 1
#endif
#ifndef REP_P9
#define REP_P9 1
#endif
#ifndef REP_P10
#define REP_P10 1
#endif
#ifndef WGM_IN
#define WGM_IN 8
#endif
#ifndef WGM_UP
#define WGM_UP 4
#endif
#ifndef WGM_SQ
#define WGM_SQ 4
#endif
__global__ void __launch_bounds__(NTHREADS, 2) mk_fwd(Args args) {
    extern __shared__ __attribute__((aligned(16))) unsigned char lds_raw[];
    Frame F;
    F.lds = (LAS unsigned char*)lds_raw;
    F.tid = threadIdx.x; F.lane = F.tid & 63; F.wave = __builtin_amdgcn_readfirstlane(F.tid >> 6);
    typedef const __attribute__((address_space(4))) Args* kargs_t;
    kargs_t ap = (kargs_t)__builtin_amdgcn_kernarg_segment_ptr();
    F.ws = ap->ws; F.x = (const float*)ap->in[0]; F.pos = (const int*)ap->in[1]; F.out = ap->out;
    unsigned* ctl = (unsigned*)(F.ws + WS_CTL);
    volatile LAS unsigned* MISC = (volatile LAS unsigned*)(F.lds + MISC_OFF);
#if MK_ONE_LAUNCH
    if (F.tid < 64) MISC[F.tid] = 0u;
    __syncthreads();
    XcdBarrier bar = xcd_barrier_post(ctl + CW_BAR, MISC);
#define GRID_BAR() xcd_barrier(bar)
#else
#define GRID_BAR() do { } while (0)
#endif
    const int lo = ap->ph_lo, hi = ap->ph_hi;
    const int G = (int)gridDim.x, bx = (int)blockIdx.x;
#define XN ((bf16_t*)(F.ws + WS_XN))
#define QA ((bf16_t*)(F.ws + WS_QA))
#define KA ((bf16_t*)(F.ws + WS_KA))
#define VA ((bf16_t*)(F.ws + WS_VA))
#define QKVD ((bf16_t*)(F.ws + WS_QKVD))
#define ZD ((bf16_t*)(F.ws + WS_ZD))
#define GA ((bf16_t*)(F.ws + WS_GA))
#define GD ((bf16_t*)(F.ws + WS_GD))
#define BAf ((float*)(F.ws + WS_BA))
#define ROPE ((float*)(F.ws + WS_ROPE))
#define Y GA
#define OA XN
#define MIX QKVD
#define UF QKVD
#define ACT ((bf16_t*)(F.ws + WS_DN))
#define FO QA
#define OD QKVD

    for (int l = 0; l < DEPTH; ++l) {
        const int pb = l * NPH;
#define IN(p) (lo <= pb + (p) && pb + (p) < hi)
#define REFRAME() do { int t_ = threadIdx.x; asm volatile("" : "+v"(t_)); F.tid = t_; F.lane = t_ & 63; F.wave = __builtin_amdgcn_readfirstlane(t_ >> 6); \
        ap = (kargs_t)__builtin_amdgcn_kernarg_segment_ptr(); asm volatile("" : "+s"(ap)); F.ws = ap->ws; F.x = (const float*)ap->in[0]; F.pos = (const int*)ap->in[1]; F.out = ap->out; } while (0)
#define SEAM(p) do { if (pb + (p) + 1 < hi) GRID_BAR(); } while (0)
#ifndef NO_P0
        if (IN(0)) { REFRAME();
            ph_convert_weights(F, ap, l);
            if (l == 0) { ph_rope_table(F); ph_norm_first(F, F.x, (const float*)ap->in[2], XN); }
            SEAM(0);
        }
#endif
#ifndef NO_P1
        if (IN(1)) { REFRAME();
            for (int rep_ = 0; rep_ < REP_P1; ++rep_) { pg8::Gemm g{XN, (const bf16_t*)(F.ws + WT_IN), T, NIN, D}; pg8::StaticOrder S; S.init(T, NIN, G, bx, WGM_IN);
            pg8::EpiInProj E{QA, KA, VA, QKVD, ZD, GA, GD, BAf, ROPE};
            pg8::gemm_phase<pg8::EpiInProj, pg8::StaticOrder, true, true>(F.lds, g, S, E);
             }
            SEAM(1);
        }
#endif
#ifndef NO_P2
        if (IN(2)) { REFRAME();
            for (int rep_ = 0; rep_ < REP_P2; ++rep_) { ph_dn_prep(F, QKVD, BAf, (const float*)ap->in[5] + (size_t)l * 4 * 6144, (const float*)ap->in[6] + l * 16, (const float*)ap->in[7] + l * 16, F.ws + WS_DN);
 }
                        SEAM(2);
        }
#endif
#ifndef NO_P3
        if (IN(3)) { REFRAME();
            { const int half = G / 2;
              const int natt = NB * 32 * 4, nrnd = (G - half) > 0 ? (natt - half) / (G - half) : 0, nfirst = nrnd * (G - half);
              if (bx < half) { for (int rs_ = 0; rs_ < REP_SCAN; ++rs_) for (int it = bx; it < NB * 16; it += half) ph_dn_scan(F, it, ZD, OD, (const float*)ap->in[8] + l * 128, F.ws + WS_DN);
#ifdef MK_ATTN_TAIL
                  ph_attn(F, QA, OA, KA, VA, (const float*)ap->in[4] + l * 16, nfirst + bx, half, natt);
#endif
              }
              else { for (int ra_ = 0; ra_ < REP_ATTN; ++ra_) ph_attn(F, QA, OA, KA, VA, (const float*)ap->in[4] + l * 16, bx - half, G - half, MK_ATTN_LAST); } }
            SEAM(3);
        }
#endif
#ifndef NO_P4
        if (IN(4)) { REFRAME();
            for (int rep_ = 0; rep_ < REP_P4; ++rep_) { pg8::Gemm g{OA, (const bf16_t*)(F.ws + WT_BA), T, D, D}; pg8::StaticOrder S; S.init(T, D, G, bx, WGM_SQ);
            pg8::EpiGate<0> E{Y, GA};
            pg8::gemm_phase<pg8::EpiGate<0>, pg8::StaticOrder, true, true>(F.lds, g, S, E);
             }
#ifndef MK_NO_SEAM4
            SEAM(4);
#endif
        }
#endif
#ifndef NO_P5
        if (IN(5)) { REFRAME();
            pg8::Gemm g{OD, (const bf16_t*)(F.ws + WT_BD), T, D, D}; pg8::StaticOrder S; S.init(T, D, G, bx, WGM_SQ);
            pg8::EpiGate<1> E{Y, GD};
            pg8::gemm_phase<pg8::EpiGate<1>, pg8::StaticOrder, true, true>(F.lds, g, S, E);
            SEAM(5);
        }
#endif
#ifndef NO_P6
        if (IN(6)) { REFRAME();
            for (int rep_ = 0; rep_ < REP_P6; ++rep_) { pg8::Gemm g{Y, (const bf16_t*)(F.ws + WT_OUT), T, D, D}; pg8::StaticOrder S; S.init(T, D, G, bx, WGM_SQ);
            pg8::EpiPlain E{MIX, D};
            pg8::gemm_phase<pg8::EpiPlain, pg8::StaticOrder, true, true>(F.lds, g, S, E);
             }
            SEAM(6);
        }
#endif
#ifndef NO_P7
        if (IN(7)) { REFRAME();
            if (l == 0) ph_norm_res<false, true>(F, MIX, (const float*)ap->in[12] + (size_t)l * D, F.x, F.out, (const float*)ap->in[13] + (size_t)l * D, XN);
            else ph_norm_res<true, true>(F, MIX, (const float*)ap->in[12] + (size_t)l * D, F.out, (l == DEPTH - 1) ? (void*)(F.ws + WS_HTAIL) : (void*)F.out, (const float*)ap->in[13] + (size_t)l * D, XN);
            SEAM(7);
        }
#endif
#ifndef NO_P8
        if (IN(8)) { REFRAME();
            for (int rep_ = 0; rep_ < REP_P8; ++rep_) { pg8::Gemm g{XN, (const bf16_t*)(F.ws + WT_UP), T, NUP, D}; pg8::StaticOrder S; S.init(T, NUP, G, bx, WGM_UP);
            pg8::EpiConvGlu E{ACT, (float*)(F.ws + WS_QKVD), (float*)(F.ws + WS_QKVD + 64 * MiB), (const float*)ap->in[15] + (size_t)l * 3 * NUP, (const float*)ap->in[16] + (size_t)l * NUP};
            pg8::gemm_phase<pg8::EpiConvGlu, pg8::StaticOrder, true, true>(F.lds, g, S, E);
             }
            SEAM(8);
        }
#endif
#ifndef NO_P9
        if (IN(9)) { REFRAME();
            for (int rep_ = 0; rep_ < REP_P9; ++rep_) { ph_ffn_fixup(F, (const float*)(F.ws + WS_QKVD), (const float*)(F.ws + WS_QKVD + 64 * MiB), (const float*)ap->in[15] + (size_t)l * 3 * NUP, ACT);
             }
            SEAM(9);
        }
#endif
#ifndef NO_P10
        if (IN(10)) { REFRAME();
            for (int rep_ = 0; rep_ < REP_P10; ++rep_) { pg8::Gemm g{ACT, (const bf16_t*)(F.ws + WT_DOWN), T, D, DFF}; pg8::StaticOrder S; S.init(T, D, G, bx, WGM_SQ);
            pg8::EpiPlain E{FO, D};
            pg8::gemm_phase<pg8::EpiPlain, pg8::StaticOrder, true, true>(F.lds, g, S, E);
             }
            SEAM(10);
        }
#endif
#ifndef NO_P11
        if (IN(11)) { REFRAME();
            if (l + 1 < DEPTH) ph_norm_res<true, true>(F, FO, (const float*)ap->in[18] + (size_t)l * D, F.out, F.out, (const float*)ap->in[2] + (size_t)(l + 1) * D, XN);
            else ph_norm_res<true, false>(F, FO, (const float*)ap->in[18] + (size_t)l * D, F.ws + WS_HTAIL, F.out, nullptr, XN);
            SEAM(11);
        }
#endif
#undef IN
#undef REFRAME
#undef SEAM
    }
}
#undef XN
#undef QA
#undef KA
#undef VA
#undef QKVD
#undef ZD
#undef GA
#undef GD
#undef BAf
#undef ROPE
#undef Y
#undef OA
#undef MIX
#undef UF
#undef ACT
#undef FO
#undef OD

extern "C" void kernel_launch(void* const* d_in, const int* in_sizes, int n_in, void* d_out, int out_size, void* d_ws, size_t ws_size, hipStream_t stream) {
    static int grid = 0;
    if (grid == 0) {
        if (n_in != 19 || out_size != T * D || ws_size < WS_END) { fprintf(stderr, "kernel_launch: unexpected problem shape (n_in %d out %d ws %zu)\n", n_in, out_size, ws_size); grid = -1; return; }
        int dev = 0, cus = 0, per_cu = 0;
        if (hipGetDevice(&dev) != hipSuccess || hipDeviceGetAttribute(&cus, hipDeviceAttributeMultiprocessorCount, dev) != hipSuccess) { grid = -1; return; }
        if (hipFuncSetAttribute((const void*)mk_fwd, hipFuncAttributeMaxDynamicSharedMemorySize, LDS_BYTES) != hipSuccess) { fprintf(stderr, "kernel_launch: hipFuncSetAttribute failed\n"); grid = -1; return; }
        if (hipOccupancyMaxActiveBlocksPerMultiprocessor(&per_cu, (const void*)mk_fwd, NTHREADS, LDS_BYTES) != hipSuccess || per_cu < 1) fprintf(stderr, "kernel_launch: occupancy query reports %d\n", per_cu);
        (void)hipGetLastError();
        grid = cus;
    }
    if (grid < 0) return;
    if (hipMemsetAsync((char*)d_ws + WS_CTL, 0, CTL_ZERO_BYTES, stream) != hipSuccess) return;
    Args a{};
    for (int i = 0; i < 19; ++i) a.in[i] = d_in[i];
    a.out = (float*)d_out; a.ws = (unsigned char*)d_ws;
#if MK_ONE_LAUNCH
    a.ph_lo = 0; a.ph_hi = NPHASES;
    hipLaunchKernelGGL(mk_fwd, dim3(grid), dim3(NTHREADS), LDS_BYTES, stream, a);
#else
    for (int p = 0; p < NPHASES; ++p) { a.ph_lo = p; a.ph_hi = p + 1; hipLaunchKernelGGL(mk_fwd, dim3(grid), dim3(NTHREADS), LDS_BYTES, stream, a);
#ifdef MK_PROBE_DUP_PHASE
        if (p % NPH == MK_PROBE_DUP_PHASE) hipLaunchKernelGGL(mk_fwd, dim3(grid), dim3(NTHREADS), LDS_BYTES, stream, a);
#endif
    }
#endif
}
```

```cpp
#include <hip/hip_runtime.h>
#include <cstdio>
#include <cstdint>

#ifndef MK_ONE_LAUNCH
#define MK_ONE_LAUNCH 1
#endif
#ifndef MK_CONVW_LDS
#define MK_CONVW_LDS 1
#endif
#ifndef MK_PRESTAGE
#define MK_PRESTAGE 1
#endif

typedef __bf16 bf16x2n_t __attribute__((ext_vector_type(2)));
typedef float f32x2n_t __attribute__((ext_vector_type(2)));
__device__ __forceinline__ unsigned pk2(float lo, float hi) { f32x2n_t v = {lo, hi}; return __builtin_bit_cast(unsigned, __builtin_convertvector(v, bf16x2n_t)); }
__device__ __forceinline__ float bf_lo(unsigned w) { return __uint_as_float(w << 16); }
__device__ __forceinline__ float bf_hi(unsigned w) { return __uint_as_float(w & 0xffff0000u); }
__device__ __forceinline__ float bf1(unsigned short h) { return __uint_as_float(((unsigned)h) << 16); }
__device__ __forceinline__ float sigmoidf_(float x) { return __builtin_amdgcn_rcpf(1.0f + __expf(-x)); }
__device__ __forceinline__ float siluf_(float x) { return x * __builtin_amdgcn_rcpf(1.0f + __expf(-x)); }

namespace pg8 {
#define PG8_LAS __attribute__((address_space(3)))
typedef unsigned short bf16_t;
typedef short bf16x8 __attribute__((ext_vector_type(8)));
typedef float f32x4 __attribute__((ext_vector_type(4)));
typedef unsigned u32x4 __attribute__((ext_vector_type(4)));
constexpr int BM = 256, BK = 64, HALF = 128, HTB = HALF * BK * 2  , STAGE_BYTES = 8 * HTB, NXCD = 8, WGM = 8;

__host__ __device__ __forceinline__ int lds_byte(int r, int c) { const int st = (r >> 4) * 2 + (c >> 5), rr = r & 15, cc = c & 31, ob = rr * 64 + cc * 2; return st * 1024 + (ob ^ (((ob >> 9) & 1) << 5)); }
__host__ __device__ __forceinline__ void stage_rc(int b, int& R, int& C) { const int st = b / 1024, sb = b % 1024, swz = sb ^ (((sb >> 9) & 1) << 5); R = (st >> 1) * 16 + swz / 64; C = (st & 1) * 32 + (swz % 64) / 2; }
__host__ __device__ __forceinline__ int perm32(int rho) { const int n = rho >> 4, i = rho & 15; return 8 * (i >> 2) + 4 * n + (i & 3); }

struct Unit { int pm, pn, idx; };
struct Gemm { const bf16_t* A; const bf16_t* Bt; int M, N, K; };

struct StaticOrder {
    int nM, nN, nwg, G, c, wgm;
    __host__ __device__ void init(int M, int N, int G_, int c_, int wgm_ = 4) { nM = M / BM; nN = N / BM; nwg = nM * nN; G = G_; c = c_; wgm = wgm_; }
    __host__ __device__ bool next(int i, Unit& u) const {
        const long L = (long)i * G + c; if (L >= nwg) return false;
        int wgid = (int)L; { const int q = nwg / NXCD, r = nwg % NXCD, xcd = wgid % NXCD, off = wgid / NXCD; wgid = (xcd < r ? xcd * (q + 1) : r * (q + 1) + (xcd - r) * q) + off; }
        const int nig = wgm * nN, gid = wgid / nig, fm = gid * wgm, gsz = (nM - fm) < wgm ? (nM - fm) : wgm;
        u.pm = fm + ((wgid % nig) % gsz); u.pn = (wgid % nig) / gsz; u.idx = i; return true;
    }
    __device__ __forceinline__ void a_ready(const Unit&) const {}
    __device__ __forceinline__ void done(const Unit&) const {}
};

__device__ __forceinline__ u32x4 pack8v(const f32x4 v0, const f32x4 v1) { u32x4 w; w.x = pk2(v0[0], v0[1]); w.y = pk2(v0[2], v0[3]); w.z = pk2(v1[0], v1[1]); w.w = pk2(v1[2], v1[3]); return w; }
__device__ __forceinline__ void unpack8v(const u32x4 w, f32x4& v0, f32x4& v1) { v0[0] = bf_lo(w.x); v0[1] = bf_hi(w.x); v0[2] = bf_lo(w.y); v0[3] = bf_hi(w.y); v1[0] = bf_lo(w.z); v1[1] = bf_hi(w.z); v1[2] = bf_lo(w.w); v1[3] = bf_hi(w.w); }

struct EpiPlain {
    static constexpr bool PERM = true, AFTER_DRAIN = false, STAGE_W = false;
    __device__ __forceinline__ int min_vm(const Unit&) const { return 16; }
    bf16_t* O; int ldc;
    __device__ __forceinline__ void operator()(const f32x4 (&acc)[2][2][4][2], const Unit& u, int wr, int wc, int fr, int fq) const {
        const int row0 = u.pm * BM + wr * 64 + fr, col0 = u.pn * BM + wc * 32 + 8 * fq;
#pragma unroll
        for (int ai = 0; ai < 2; ++ai)
#pragma unroll
            for (int m = 0; m < 4; ++m) { bf16_t* rowp = O + (size_t)(row0 + ai * HALF + m * 16) * ldc + col0;
#pragma unroll
                for (int bj = 0; bj < 2; ++bj) *(u32x4*)(rowp + bj * HALF) = pack8v(acc[ai][bj][m][0], acc[ai][bj][m][1]); }
    }
};

#ifdef PROBE_DOWN_C
struct EpiNull {
    static constexpr bool PERM = true, AFTER_DRAIN = false, STAGE_W = false;
    __device__ __forceinline__ int min_vm(const Unit&) const { return 0; }
    bf16_t* O; int ldc;
    __device__ __forceinline__ void operator()(const f32x4 (&acc)[2][2][4][2], const Unit& u, int wr, int wc, int fr, int fq) const {
        float s = 0.f;
#pragma unroll
        for (int ai = 0; ai < 2; ++ai)
#pragma unroll
            for (int bj = 0; bj < 2; ++bj)
#pragma unroll
            for (int m = 0; m < 4; ++m)
#pragma unroll
            for (int n = 0; n < 2; ++n) s += acc[ai][bj][m][n][0] + acc[ai][bj][m][n][1] + acc[ai][bj][m][n][2] + acc[ai][bj][m][n][3];
        if (s == 123456.789f) O[(size_t)(u.pm * BM + wr * 64 + fr) * ldc + u.pn * BM + wc * 32 + 8 * fq] = (bf16_t)1;
    }
};
#endif
struct EpiInProj {
    static constexpr bool PERM = true, AFTER_DRAIN = false, STAGE_W = false;
    __device__ __forceinline__ int min_vm(const Unit& u) const { return u.pn == 60 ? 0 : 16; }
    bf16_t *QA, *KA, *VA, *QKVD, *ZD, *GA, *GD; float* BAf; const float* rope;
    __device__ __forceinline__ void operator()(const f32x4 (&acc)[2][2][4][2], const Unit& u, int wr, int wc, int fr, int fq) const {
        const int pn = u.pn; const int row0 = u.pm * BM + wr * 64 + fr;
        if (pn == 60) {
            if (wc == 0) {
#pragma unroll
                for (int ai = 0; ai < 2; ++ai)
#pragma unroll
                    for (int m = 0; m < 4; ++m) { float* p = BAf + (size_t)(row0 + ai * HALF + m * 16) * 32 + 8 * fq; *(f32x4*)p = acc[ai][0][m][0]; *(f32x4*)(p + 4) = acc[ai][0][m][1]; }
            }
            return;
        }
        bf16_t* base; int ldc, colt; bool rope_on = false;
        if (pn < 8) { base = QA; ldc = 2048; colt = pn * 256; rope_on = true; }
        else if (pn < 10) { base = KA; ldc = 512; colt = (pn - 8) * 256; rope_on = true; }
        else if (pn < 12) { base = VA; ldc = 512; colt = (pn - 10) * 256; }
        else if (pn < 36) { base = QKVD; ldc = 6144; colt = (pn - 12) * 256; }
        else if (pn < 44) { base = ZD; ldc = 2048; colt = (pn - 36) * 256; }
        else if (pn < 52) { base = GA; ldc = 2048; colt = (pn - 44) * 256; }
        else { base = GD; ldc = 2048; colt = (pn - 52) * 256; }
        const int col0 = colt + wc * 32 + 8 * fq;
        const bool do_rope = rope_on && (wc == 0);
        const float sg = (fq < 2) ? -1.f : 1.f;
#pragma unroll
        for (int ai = 0; ai < 2; ++ai)
#pragma unroll
            for (int m = 0; m < 4; ++m) { const int row = row0 + ai * HALF + m * 16; bf16_t* rowp = base + (size_t)row * ldc + col0;
                f32x4 c0 = {1.f, 1.f, 1.f, 1.f}, c1 = c0, s0 = {0.f, 0.f, 0.f, 0.f}, s1 = s0;
                if (do_rope) { const float* rp = rope + (size_t)row * 32 + 8 * (fq & 1); c0 = *(const f32x4*)rp; c1 = *(const f32x4*)(rp + 4); s0 = *(const f32x4*)(rp + 16); s1 = *(const f32x4*)(rp + 20); }
#pragma unroll
                for (int bj = 0; bj < 2; ++bj) { f32x4 v0 = acc[ai][bj][m][0], v1 = acc[ai][bj][m][1];
                    if (do_rope) { f32x4 p0, p1;
#pragma unroll
                        for (int e = 0; e < 4; ++e) { p0[e] = __shfl_xor(v0[e], 32); p1[e] = __shfl_xor(v1[e], 32); }
                        v0 = v0 * c0 + sg * (p0 * s0); v1 = v1 * c1 + sg * (p1 * s1); }
                    *(u32x4*)(rowp + bj * HALF) = pack8v(v0, v1); } }
    }
};

template <int MODE> struct EpiGate {
    static constexpr bool PERM = true, AFTER_DRAIN = false, STAGE_W = false;
    static constexpr int B = (MODE == 0) ? 8 : 4, NBATCH = 16 / B;
    __device__ __forceinline__ int min_vm(const Unit&) const { return 16; }
    bf16_t* Y; const bf16_t* G;
    __device__ __forceinline__ void operator()(const f32x4 (&acc)[2][2][4][2], const Unit& u, int wr, int wc, int fr, int fq) const {
        const int row0 = u.pm * BM + wr * 64 + fr, col0 = u.pn * BM + wc * 32 + 8 * fq;
#define EG_OFF(k) ((size_t)(row0 + ((k) >> 3) * HALF + (((k) >> 1) & 3) * 16) * 2048 + col0 + ((k) & 1) * HALF)
        u32x4 gb[2][B], yb[2][B];
#pragma unroll
        for (int j = 0; j < B; ++j) { gb[0][j] = *(const u32x4*)(G + EG_OFF(j)); if (MODE == 1) yb[0][j] = *(const u32x4*)(Y + EG_OFF(j)); }
#pragma unroll
        for (int b = 0; b < NBATCH; ++b) {
            if (b + 1 < NBATCH) {
#pragma unroll
                for (int j = 0; j < B; ++j) { gb[(b + 1) & 1][j] = *(const u32x4*)(G + EG_OFF((b + 1) * B + j)); if (MODE == 1) yb[(b + 1) & 1][j] = *(const u32x4*)(Y + EG_OFF((b + 1) * B + j)); } }
#pragma unroll
            for (int j = 0; j < B; ++j) { const int k = b * B + j, ai = k >> 3, m = (k >> 1) & 3, bj = k & 1;
                f32x4 g0, g1; unpack8v(gb[b & 1][j], g0, g1);
                f32x4 v0 = acc[ai][bj][m][0], v1 = acc[ai][bj][m][1];
#pragma unroll
                for (int e2 = 0; e2 < 4; ++e2) { v0[e2] *= sigmoidf_(g0[e2]); v1[e2] *= sigmoidf_(g1[e2]); }
                if (MODE == 1) { f32x4 y0, y1; unpack8v(yb[b & 1][j], y0, y1); v0 += y0; v1 += y1; }
                *(u32x4*)(Y + EG_OFF(k)) = pack8v(v0, v1); }
        }
#undef EG_OFF
    }
};

__device__ __forceinline__ float dpp_ror1(float v) { return __builtin_bit_cast(float, __builtin_amdgcn_update_dpp(0, __builtin_bit_cast(int, v), 0x121, 0xf, 0xf, false)); }
__device__ __forceinline__ float dpp_ror2(float v) { return __builtin_bit_cast(float, __builtin_amdgcn_update_dpp(0, __builtin_bit_cast(int, v), 0x122, 0xf, 0xf, false)); }
__device__ __forceinline__ float dpp_shr1(float v) { return __builtin_bit_cast(float, __builtin_amdgcn_update_dpp(0, __builtin_bit_cast(int, v), 0x111, 0xf, 0xf, true)); }
__device__ __forceinline__ float dpp_shr2(float v) { return __builtin_bit_cast(float, __builtin_amdgcn_update_dpp(0, __builtin_bit_cast(int, v), 0x112, 0xf, 0xf, true)); }
__device__ __forceinline__ float dpp_shl15(float v) { return __builtin_bit_cast(float, __builtin_amdgcn_update_dpp(0, __builtin_bit_cast(int, v), 0x10F, 0xf, 0xf, true)); }
__device__ __forceinline__ float dpp_shl14(float v) { return __builtin_bit_cast(float, __builtin_amdgcn_update_dpp(0, __builtin_bit_cast(int, v), 0x10E, 0xf, 0xf, true)); }
typedef unsigned u32x2e __attribute__((ext_vector_type(2)));
struct EpiConvGlu {
    static constexpr bool PERM = true, AFTER_DRAIN = false, STAGE_W = (MK_CONVW_LDS != 0);
    __device__ __forceinline__ int min_vm(const Unit&) const { return 16; }
    bf16_t* ACT; float* PART; float* TAIL; const float* cw; const float* cb;
    PG8_LAS unsigned char* wl;
    __device__ __forceinline__ void stage_w(const Unit& u, int wid, int lane) const {
        if (wid < 4) { const float* src = ((wid < 3) ? cw + wid * 11264 : cb) + ((lane < 32) ? 0 : 5632) + u.pn * 128 + 4 * (lane & 31);
            __builtin_amdgcn_global_load_lds((const unsigned*)src, (PG8_LAS unsigned*)(wl + (u.idx & 1) * 4096 + wid * 1024), 16, 0, 0); }
    }
    __device__ __forceinline__ void operator()(const f32x4 (&acc)[2][2][4][2], const Unit& u, int wr, int wc, int fr, int fq) const {
#pragma unroll
        for (int n = 0; n < 2; ++n) {
            const int ch = u.pn * 128 + wc * 32 + 8 * fq + 4 * n;
            f32x4 wg[3], wv[3], bg, bv;
            if constexpr (STAGE_W) { const PG8_LAS float* wb = (const PG8_LAS float*)(wl + (u.idx & 1) * 4096) + wc * 32 + 8 * fq + 4 * n;
#pragma unroll
                for (int j = 0; j < 3; ++j) { wg[j] = *(const PG8_LAS f32x4*)(wb + j * 256); wv[j] = *(const PG8_LAS f32x4*)(wb + j * 256 + 128); }
                bg = *(const PG8_LAS f32x4*)(wb + 768); bv = *(const PG8_LAS f32x4*)(wb + 768 + 128);
            } else {
#pragma unroll
                for (int j = 0; j < 3; ++j) { wg[j] = *(const f32x4*)(cw + j * 11264 + ch); wv[j] = *(const f32x4*)(cw + j * 11264 + 5632 + ch); }
                bg = *(const f32x4*)(cb + ch); bv = *(const f32x4*)(cb + 5632 + ch); }
#pragma unroll
            for (int ai = 0; ai < 2; ++ai) {
                const int brow0 = u.pm * BM + ai * HALF + wr * 64, gb = brow0 >> 6;
#pragma unroll
                for (int m = 0; m < 4; ++m) {
                    f32x4 g, v;
#pragma unroll
                    for (int e = 0; e < 4; e += 2) {
                        const float cg0 = acc[ai][0][m][n][e], cv0 = acc[ai][1][m][n][e], cg1 = acc[ai][0][m][n][e + 1], cv1 = acc[ai][1][m][n][e + 1];
                        float g0 = fmaf(wg[2][e], cg0, bg[e]), v0 = fmaf(wv[2][e], cv0, bv[e]), g1 = fmaf(wg[2][e + 1], cg1, bg[e + 1]), v1 = fmaf(wv[2][e + 1], cv1, bv[e + 1]);
                        asm volatile("s_nop 1\n\t"
                            "v_fmac_f32_dpp %0, %4, %8 row_shr:1 row_mask:0xf bank_mask:0xf\n\t"
                            "v_fmac_f32_dpp %1, %5, %9 row_shr:1 row_mask:0xf bank_mask:0xf\n\t"
                            "v_fmac_f32_dpp %2, %6, %10 row_shr:1 row_mask:0xf bank_mask:0xf\n\t"
                            "v_fmac_f32_dpp %3, %7, %11 row_shr:1 row_mask:0xf bank_mask:0xf\n\t"
                            "v_fmac_f32_dpp %0, %4, %12 row_shr:2 row_mask:0xf bank_mask:0xf\n\t"
                            "v_fmac_f32_dpp %1, %5, %13 row_shr:2 row_mask:0xf bank_mask:0xf\n\t"
                            "v_fmac_f32_dpp %2, %6, %14 row_shr:2 row_mask:0xf bank_mask:0xf\n\t"
                            "v_fmac_f32_dpp %3, %7, %15 row_shr:2 row_mask:0xf bank_mask:0xf"
                            : "+v"(g0), "+v"(v0), "+v"(g1), "+v"(v1)
                            : "v"(cg0), "v"(cv0), "v"(cg1), "v"(cv1), "v"(wg[1][e]), "v"(wv[1][e]), "v"(wg[1][e + 1]), "v"(wv[1][e + 1]), "v"(wg[0][e]), "v"(wv[0][e]), "v"(wg[0][e + 1]), "v"(wv[0][e + 1]));
                        if (m > 0) { const float pg0 = acc[ai][0][m - 1][n][e], pv0 = acc[ai][1][m - 1][n][e], pg1 = acc[ai][0][m - 1][n][e + 1], pv1 = acc[ai][1][m - 1][n][e + 1];
                            asm volatile("s_nop 1\n\t"
                                "v_fmac_f32_dpp %0, %4, %8 row_shl:15 row_mask:0xf bank_mask:0xf\n\t"
                                "v_fmac_f32_dpp %1, %5, %9 row_shl:15 row_mask:0xf bank_mask:0xf\n\t"
                                "v_fmac_f32_dpp %2, %6, %10 row_shl:15 row_mask:0xf bank_mask:0xf\n\t"
                                "v_fmac_f32_dpp %3, %7, %11 row_shl:15 row_mask:0xf bank_mask:0xf\n\t"
                                "v_fmac_f32_dpp %0, %4, %12 row_shl:14 row_mask:0xf bank_mask:0xf\n\t"
                                "v_fmac_f32_dpp %1, %5, %13 row_shl:14 row_mask:0xf bank_mask:0xf\n\t"
                                "v_fmac_f32_dpp %2, %6, %14 row_shl:14 row_mask:0xf bank_mask:0xf\n\t"
                                "v_fmac_f32_dpp %3, %7, %15 row_shl:14 row_mask:0xf bank_mask:0xf"
                                : "+v"(g0), "+v"(v0), "+v"(g1), "+v"(v1)
                                : "v"(pg0), "v"(pv0), "v"(pg1), "v"(pv1), "v"(wg[1][e]), "v"(wv[1][e]), "v"(wg[1][e + 1]), "v"(wv[1][e + 1]), "v"(wg[0][e]), "v"(wv[0][e]), "v"(wg[0][e + 1]), "v"(wv[0][e + 1])); }
                        g[e] = g0; v[e] = v0; g[e + 1] = g1; v[e + 1] = v1;
                    }
                    const int row = brow0 + 16 * m + fr;
                    if (m == 0 && fr < 2) {
                        float* pp = PART + (size_t)(gb * 2 + fr) * 11264 + ch;
                        *(f32x4*)pp = g; *(f32x4*)(pp + 5632) = v;
                    } else {
                        u32x2e w; w.x = pk2(siluf_(g[0]) * v[0], siluf_(g[1]) * v[1]); w.y = pk2(siluf_(g[2]) * v[2], siluf_(g[3]) * v[3]);
                        *(u32x2e*)(ACT + (size_t)row * 5632 + ch) = w;
                    }
                    if (m == 3 && fr >= 14) {
                        float* tp = TAIL + (size_t)(gb * 2 + (fr - 14)) * 11264 + ch;
                        *(f32x4*)tp = acc[ai][0][3][n]; *(f32x4*)(tp + 5632) = acc[ai][1][3][n];
                    }
                }
            }
        }
    }
};

template <class Epi, class Sched, bool ALIGN_EPI = false, bool SP2 = false, bool PRE = false>
__device__ __forceinline__ void gemm_phase(PG8_LAS unsigned char* lds, const Gemm g, const Sched& S, const Epi& E) {
    int tid_ = threadIdx.x; asm volatile("" : "+v"(tid_));
    const int tid = tid_, wid = __builtin_amdgcn_readfirstlane(tid >> 6), lane = tid & 63, wr = wid >> 2, wc = wid & 3, fr = lane & 15, fq = lane >> 4;
    const int K = g.K, nt = K / BK;
    unsigned voffA[2], voffB[2];
#pragma unroll
    for (int i = 0; i < 2; ++i) { int R, C; stage_rc(tid * 16 + i * 8192, R, C); const int Rb = Epi::PERM ? ((R & ~31) + perm32(R & 31)) : R;
        voffA[i] = (unsigned)(R * K + C) * 2u; voffB[i] = (unsigned)(Rb * K + C) * 2u; }
    const size_t kstep = (size_t)(BK * 2);
    const size_t hstep = (size_t)HALF * K * 2;
    const size_t tstep = 2 * hstep;
    const unsigned ldsw = (unsigned)wid * 1024u;
    const int aoff = lds_byte(wr * 64 + fr, fq * 8), boff = lds_byte(wc * 32 + fr, fq * 8);
#define PG8_SA(b, h) (((b) * 2 + (h)) * HTB)
#define PG8_SB(b, h) ((4 + (b) * 2 + (h)) * HTB)
#define PG8_STAGE(bufoff, gbase, voff) do { _Pragma("unroll") for (int _i = 0; _i < 2; ++_i) \
        __builtin_amdgcn_global_load_lds((const unsigned*)((const char*)(gbase) + (voff)[_i]), (PG8_LAS unsigned*)(lds + (bufoff) + ldsw + _i * 8192), 16, 0, 0); } while (0)
#define PG8_LDA(dst, b, h) do { _Pragma("unroll") for (int m = 0; m < 4; ++m) _Pragma("unroll") for (int k = 0; k < 2; ++k) dst[m][k] = *(const PG8_LAS bf16x8*)(lds + PG8_SA(b, h) + aoff + m * 2048 + k * 1024); } while (0)
#define PG8_LDB(dst, b, h) do { _Pragma("unroll") for (int n = 0; n < 2; ++n) _Pragma("unroll") for (int k = 0; k < 2; ++k) dst[n][k] = *(const PG8_LAS bf16x8*)(lds + PG8_SB(b, h) + boff + n * 2048 + k * 1024); } while (0)
#define PG8_MMA(ai, bj, At, Bt) do { __builtin_amdgcn_s_setprio(1); _Pragma("unroll") for (int m = 0; m < 4; ++m) _Pragma("unroll") for (int n = 0; n < 2; ++n) _Pragma("unroll") for (int k = 0; k < 2; ++k) \
        acc[ai][bj][m][n] = __builtin_amdgcn_mfma_f32_16x16x32_bf16(Bt[n][k], At[m][k], acc[ai][bj][m][n], 0, 0, 0); __builtin_amdgcn_s_setprio(0); } while (0)
#define PG8_WAIT_V(n) asm volatile("s_waitcnt vmcnt(" #n ")" ::: "memory")
#define PG8_WAIT_L(n) asm volatile("s_waitcnt lgkmcnt(" #n ")" ::: "memory")
#define PG8_BAR __builtin_amdgcn_s_barrier()
#define PG8_SCHED __builtin_amdgcn_sched_barrier(0)
    Unit cur, nxt; int ui = 0;
    constexpr bool PRESTAGE = ALIGN_EPI && SP2 && PRE; bool relax = false;
    if (!S.next(0, cur)) return;
    if constexpr (Epi::STAGE_W) E.stage_w(cur, wid, lane);
    f32x4 acc[2][2][4][2];
#pragma unroll
    for (int a = 0; a < 2; ++a)
#pragma unroll
        for (int b = 0; b < 2; ++b)
#pragma unroll
            for (int m = 0; m < 4; ++m)
#pragma unroll
                for (int n = 0; n < 2; ++n) acc[a][b][m][n] = (f32x4){0.f, 0.f, 0.f, 0.f};
    bf16x8 At[4][2], B0[2][2], B1[2][2];
    const char* cA = (const char*)g.A + (size_t)cur.pm * tstep; const char* cB = (const char*)g.Bt + (size_t)cur.pn * tstep;
    S.a_ready(cur);
    if constexpr (SP2) {
        PG8_STAGE(PG8_SB(0, 0), cB, voffB); PG8_STAGE(PG8_SB(0, 1), cB + hstep, voffB); PG8_STAGE(PG8_SA(0, 0), cA, voffA); PG8_STAGE(PG8_SA(0, 1), cA + hstep, voffA);
        if (wr == 1) PG8_BAR;
        PG8_WAIT_V(2); PG8_BAR;
        PG8_STAGE(PG8_SB(1, 0), cB + kstep, voffB); PG8_STAGE(PG8_SA(1, 0), cA + kstep, voffA); PG8_STAGE(PG8_SB(1, 1), cB + hstep + kstep, voffB);
        PG8_WAIT_V(6); PG8_BAR;
        if constexpr (PRESTAGE) PG8_STAGE(PG8_SA(1, 1), cA + kstep + hstep, voffA);
    } else {
        PG8_STAGE(PG8_SB(0, 0), cB, voffB); PG8_STAGE(PG8_SA(0, 0), cA, voffA); PG8_STAGE(PG8_SB(0, 1), cB + hstep, voffB); PG8_STAGE(PG8_SA(0, 1), cA + hstep, voffA);
        if (wr == 1) PG8_BAR;
        PG8_WAIT_V(4); PG8_BAR;
        PG8_STAGE(PG8_SB(1, 0), cB + kstep, voffB); PG8_STAGE(PG8_SA(1, 0), cA + kstep, voffA); PG8_STAGE(PG8_SB(1, 1), cB + hstep + kstep, voffB);
        PG8_WAIT_V(6); PG8_BAR;
    }
    for (;;) {
        const bool has_next = S.next(ui + 1, nxt);
        const char* nA = has_next ? (const char*)g.A + (size_t)nxt.pm * tstep : cA; const char* nB = has_next ? (const char*)g.Bt + (size_t)nxt.pn * tstep : cB;
        for (int t = 0; t < nt; t += 2) {
            const bool last = (t == nt - 2);
            const char* a1 = cA + (size_t)(t + 1) * kstep;
            const char* a2 = last ? nA : cA + (size_t)(t + 2) * kstep; const char* b2 = last ? nB : cB + (size_t)(t + 2) * kstep;
            const char* a3 = a2 + kstep; const char* b3 = b2 + kstep;
            if (last && has_next) S.a_ready(nxt);
            if constexpr (SP2) {
            int tz_ = t; if constexpr (PRESTAGE) asm volatile("" : "+s"(tz_));
            const bool rx = PRESTAGE && tz_ == 0 && ui > 0 && relax;
#define PG8_WAIT_R() do { if constexpr (PRESTAGE) { PG8_WAIT_V(24); if (!rx) PG8_WAIT_V(8); } else PG8_WAIT_V(8); } while (0)
            PG8_LDB(B0, 0, 0); PG8_LDB(B1, 0, 1); PG8_SCHED; PG8_LDA(At, 0, 0); if constexpr (!PRESTAGE) PG8_STAGE(PG8_SA(1, 1), a1 + hstep, voffA);
            PG8_WAIT_R(); PG8_WAIT_L(0); PG8_BAR; PG8_MMA(0, 0, At, B0); PG8_MMA(0, 1, At, B1); PG8_BAR; PG8_SCHED;
            PG8_LDA(At, 0, 1); PG8_STAGE(PG8_SB(0, 0), b2, voffB); PG8_STAGE(PG8_SB(0, 1), b2 + hstep, voffB); PG8_STAGE(PG8_SA(0, 0), a2, voffA);
            PG8_WAIT_R(); PG8_WAIT_L(0); PG8_BAR; PG8_MMA(1, 0, At, B0); PG8_MMA(1, 1, At, B1); PG8_BAR; PG8_SCHED;
            PG8_LDB(B0, 1, 0); PG8_LDB(B1, 1, 1); PG8_SCHED; PG8_LDA(At, 1, 0); PG8_STAGE(PG8_SA(0, 1), a2 + hstep, voffA);
            PG8_WAIT_R(); PG8_WAIT_L(0); PG8_BAR; PG8_MMA(0, 0, At, B0); PG8_MMA(0, 1, At, B1); PG8_BAR; PG8_SCHED;
            PG8_LDA(At, 1, 1); PG8_STAGE(PG8_SB(1, 0), b3, voffB); PG8_STAGE(PG8_SB(1, 1), b3 + hstep, voffB); PG8_STAGE(PG8_SA(1, 0), a3, voffA);
            PG8_WAIT_V(8); PG8_WAIT_L(0); PG8_BAR; PG8_MMA(1, 0, At, B0); PG8_MMA(1, 1, At, B1); PG8_BAR; PG8_SCHED;
            if constexpr (PRESTAGE) PG8_STAGE(PG8_SA(1, 1), a3 + hstep, voffA);
#undef PG8_WAIT_R
            } else {
            PG8_LDB(B0, 0, 0); PG8_SCHED; PG8_LDA(At, 0, 0); PG8_STAGE(PG8_SA(1, 1), a1 + hstep, voffA);
            PG8_WAIT_L(8); PG8_BAR; PG8_WAIT_L(0); PG8_MMA(0, 0, At, B0); PG8_BAR; PG8_SCHED;
            PG8_LDB(B1, 0, 1); PG8_STAGE(PG8_SB(0, 0), b2, voffB);
            PG8_BAR; PG8_WAIT_L(0); PG8_MMA(0, 1, At, B1); PG8_BAR;
            PG8_LDA(At, 0, 1); PG8_STAGE(PG8_SA(0, 0), a2, voffA);
            PG8_BAR; PG8_WAIT_L(0); PG8_MMA(1, 0, At, B0); PG8_BAR; PG8_SCHED;
            PG8_STAGE(PG8_SB(0, 1), b2 + hstep, voffB);
            PG8_WAIT_V(6); PG8_BAR; PG8_MMA(1, 1, At, B1); PG8_BAR;
            PG8_LDB(B0, 1, 0); PG8_SCHED; PG8_LDA(At, 1, 0); PG8_STAGE(PG8_SA(0, 1), a2 + hstep, voffA);
            PG8_WAIT_L(8); PG8_BAR; PG8_WAIT_L(0); PG8_MMA(0, 0, At, B0); PG8_BAR; PG8_SCHED;
            PG8_LDB(B1, 1, 1); PG8_STAGE(PG8_SB(1, 0), b3, voffB);
            PG8_BAR; PG8_WAIT_L(0); PG8_MMA(0, 1, At, B1); PG8_BAR;
            PG8_LDA(At, 1, 1); PG8_STAGE(PG8_SA(1, 0), a3, voffA);
            PG8_BAR; PG8_WAIT_L(0); PG8_MMA(1, 0, At, B0); PG8_BAR; PG8_SCHED;
            PG8_STAGE(PG8_SB(1, 1), b3 + hstep, voffB);
            PG8_WAIT_V(6); PG8_BAR; PG8_MMA(1, 1, At, B1); PG8_BAR;
            }
        }
        if constexpr (ALIGN_EPI) { if (wr == 0) PG8_BAR; }
        if constexpr (PRESTAGE) relax = E.min_vm(cur) >= 16;
        if constexpr (Epi::STAGE_W) { if (has_next) E.stage_w(nxt, wid, lane); }
        if constexpr (!Epi::AFTER_DRAIN) { E(acc, cur, wr, wc, fr, fq); S.done(cur); }
        if (!has_next) break;
#pragma unroll
        for (int a = 0; a < 2; ++a)
#pragma unroll
            for (int b = 0; b < 2; ++b)
#pragma unroll
                for (int m = 0; m < 4; ++m)
#pragma unroll
                    for (int n = 0; n < 2; ++n) acc[a][b][m][n] = (f32x4){0.f, 0.f, 0.f, 0.f};
        cur = nxt; cA = nA; cB = nB; ++ui;
        if constexpr (ALIGN_EPI) { if (wr == 1) PG8_BAR; }
    }
    PG8_WAIT_V(0);
    if constexpr (!ALIGN_EPI) { if (wr == 0) PG8_BAR; }
    PG8_BAR;
    if constexpr (Epi::AFTER_DRAIN) { E.fused(acc, cur, wr, wc, fr, fq, lds, wid, lane); S.done(cur); }
#undef PG8_SA
#undef PG8_SB
#undef PG8_STAGE
#undef PG8_LDA
#undef PG8_LDB
#undef PG8_MMA
#undef PG8_WAIT_V
#undef PG8_WAIT_L
#undef PG8_BAR
#undef PG8_SCHED
}
}

#define LAS __attribute__((address_space(3)))
typedef unsigned short bf16_t;
typedef float f32x4 __attribute__((ext_vector_type(4)));
typedef unsigned u32x4 __attribute__((ext_vector_type(4)));
typedef unsigned u32x2 __attribute__((ext_vector_type(2)));
constexpr int NB = 8, SEQ = 4096, T = NB * SEQ, D = 2048, DEPTH = 4;
constexpr int NIN_ORIG = 15392, NIN = 15616, DFF = 5632, NUP = 2 * DFF;
constexpr int NWAVES = 8, NTHREADS = 512;
constexpr float EPS = 1e-6f;
constexpr int NPH = 12;
constexpr int NPHASES = DEPTH * NPH;

constexpr size_t MiB = 1ull << 20;
constexpr size_t WS_CTL = 0, CTL_ZERO_BYTES = 1 * MiB;
constexpr size_t WS_ROPE = 1 * MiB;
constexpr size_t WS_BA = 5 * MiB;
constexpr size_t WT_IN = 16 * MiB, WT_BA = 77 * MiB, WT_BD = 85 * MiB, WT_OUT = 93 * MiB, WT_UP = 101 * MiB, WT_DOWN = 145 * MiB;
constexpr size_t WS_XN = 168 * MiB;
constexpr size_t WS_QA = 296 * MiB;
constexpr size_t WS_KA = 424 * MiB, WS_VA = 456 * MiB;
constexpr size_t WS_QKVD = 488 * MiB;
constexpr size_t WS_ZD = 872 * MiB;
constexpr size_t WS_GA = 1000 * MiB, WS_GD = 1128 * MiB;
constexpr size_t WS_DN = 1256 * MiB;
constexpr size_t WS_HTAIL = 1640 * MiB;
constexpr size_t WS_END = 1834 * MiB;
constexpr int CW_BAR = 4096;
constexpr int CW_QUEUE = 16384;

constexpr int LDS_BYTES = 163840;
constexpr int MISC_OFF = 163840 - 256;

#define VM_WAIT() asm volatile("s_waitcnt vmcnt(0)" ::: "memory")
#define LDS_BARRIER() do { asm volatile("s_waitcnt lgkmcnt(0)" ::: "memory"); __builtin_amdgcn_s_barrier(); asm volatile("" ::: "memory"); } while (0)

#define XB_TMO      128
#define XB_XCNT(j)  (256  + 64 * (j))
#define XB_XSUB(j)  (1280 + 64 * (j))
#define XB_XGEN(j)  (2304 + 64 * (j))
#define XB_TOP      3328
#define XB_TOPGEN   3392
#define XCD_BAR_WORDS 3456
#define XB_SPIN_CAP (1u << 22)

__device__ __forceinline__ unsigned xb_ld(unsigned* p)              { return __hip_atomic_load(p, __ATOMIC_RELAXED, __HIP_MEMORY_SCOPE_AGENT); }
__device__ __forceinline__ unsigned xb_add(unsigned* p, unsigned v) { return __hip_atomic_fetch_add(p, v, __ATOMIC_RELAXED, __HIP_MEMORY_SCOPE_AGENT); }
__device__ __forceinline__ unsigned xb_xcc_id() { return (unsigned)__builtin_amdgcn_s_getreg((3 << 11) | 20) & 0xFu; }
#define XB_SPIN(cond, bar) do { unsigned _sp = 0; while (cond) { __builtin_amdgcn_s_sleep(1); \
    if ((++_sp & 255u) == 0u) { if (xb_ld(&(bar)[XB_TMO])) break; if (_sp > XB_SPIN_CAP) { atomicAdd(&(bar)[XB_TMO], 1u); break; } } } } while (0)

struct XcdBarrier {
    unsigned* bar; unsigned x;
    volatile LAS unsigned* st;
};
__device__ __forceinline__ XcdBarrier xcd_barrier_post(unsigned* bar, volatile LAS unsigned* st) {
    XcdBarrier b; b.bar = bar; b.x = xb_xcc_id(); b.st = st;
    if (threadIdx.x == 0) (void)xb_add(&bar[XB_XCNT(b.x)], 1u);
    return b;
}
__device__ __forceinline__ void xcd_barrier_complete(unsigned* bar, unsigned x, unsigned& nloc, unsigned& nx) {
    const unsigned G = gridDim.x * gridDim.y * gridDim.z;
    unsigned sum, cnt, mine, sp = 0u;
    for (;;) {
        sum = 0u; cnt = 0u; mine = 0u;
#pragma unroll
        for (unsigned j = 0; j < 16; ++j) { const unsigned c = xb_ld(&bar[XB_XCNT(j)]); sum += c; cnt += (c > 0u) ? 1u : 0u; mine = (j == x) ? c : mine; }
        if (sum == G) break;
        __builtin_amdgcn_s_sleep(1);
        if ((++sp & 255u) == 0u) { if (xb_ld(&bar[XB_TMO])) break; if (sp > XB_SPIN_CAP) { atomicAdd(&bar[XB_TMO], 1u); break; } }
    }
    nloc = mine > 0u ? mine : 1u; nx = cnt > 0u ? cnt : 1u;
}
__device__ __forceinline__ void xcd_barrier(const XcdBarrier& b) {
    asm volatile("s_waitcnt vmcnt(0)" ::: "memory");
    __syncthreads();
    if (threadIdx.x == 0) {
        unsigned* bar = b.bar;
        __builtin_amdgcn_s_waitcnt(0);
        unsigned nloc = b.st[0], nx = b.st[1];
        if (nloc == 0u) { xcd_barrier_complete(bar, b.x, nloc, nx); b.st[0] = nloc; b.st[1] = nx; }
        const unsigned old = xb_add(&bar[XB_XSUB(b.x)], 1u);
        const unsigned gen = old / nloc;
        if (old + 1u == (gen + 1u) * nloc) {
            __builtin_amdgcn_fence(__ATOMIC_RELEASE, "agent");
            asm volatile("s_waitcnt vmcnt(0)" ::: "memory");
            const unsigned og = xb_add(&bar[XB_TOP], 1u);
            const unsigned tg = og / nx;
            if (og + 1u == (tg + 1u) * nx) xb_add(&bar[XB_TOPGEN], 1u);
            else XB_SPIN(xb_ld(&bar[XB_TOPGEN]) == tg, bar);
            __builtin_amdgcn_fence(__ATOMIC_ACQUIRE, "agent");
            xb_add(&bar[XB_XGEN(b.x)], 1u);
            asm volatile("s_waitcnt vmcnt(0)" ::: "memory");
        } else {
            XB_SPIN(xb_ld(&bar[XB_XGEN(b.x)]) == gen, bar);
            __builtin_amdgcn_fence(__ATOMIC_ACQUIRE, "agent");
            asm volatile("s_waitcnt vmcnt(0)" ::: "memory");
        }
    }
    __syncthreads();
}

struct Args { const void* in[19]; float* out; unsigned char* ws; int ph_lo, ph_hi; };
struct Frame {
    LAS unsigned char* lds;
    int tid, lane, wave;
    unsigned char* ws;
    const float* x; const int* pos; float* out;
};

__device__ __forceinline__ float wave_sum(float v) {
#pragma unroll
    for (int o = 1; o < 64; o <<= 1) v += __shfl_xor(v, o);
    return v;
}
__device__ __forceinline__ float wave_max(float v) {
#pragma unroll
    for (int o = 1; o < 64; o <<= 1) v = fmaxf(v, __shfl_xor(v, o));
    return v;
}

__device__ __forceinline__ void transpose_item(const float* W, int K, int N, bf16_t* WT, LAS float* scr, int item, int lane, int remap) {
    const int nblk = N / 32, kb = item / nblk, nb = item % nblk, k0 = 64 * kb, n0 = 32 * nb;
    int n0d = n0;
    if (remap == 1) n0d = (n0 < 9216) ? n0 : ((n0 == 9216) ? 15360 : n0 - 32);
    if (remap == 2) { const int cch = (n0 < DFF) ? n0 : n0 - DFF; n0d = 256 * (cch >> 7) + ((n0 < DFF) ? 0 : 128) + (cch & 127); }
#pragma unroll 8
    for (int i = 0; i < 32; ++i) { const int kk = 2 * i + (lane >> 5); scr[kk * 33 + (lane & 31)] = W[(size_t)(k0 + kk) * N + n0 + (lane & 31)]; }
    asm volatile("s_waitcnt lgkmcnt(0)" ::: "memory");
    const int c = lane & 7;
#pragma unroll
    for (int j = 0; j < 4; ++j) { const int n = (lane >> 3) + 8 * j; const LAS float* s = scr + (8 * c) * 33 + n;
        u32x4 o; o.x = pk2(s[0 * 33], s[1 * 33]); o.y = pk2(s[2 * 33], s[3 * 33]); o.z = pk2(s[4 * 33], s[5 * 33]); o.w = pk2(s[6 * 33], s[7 * 33]);
        *(u32x4*)(WT + (size_t)(n0d + n) * K + k0 + 8 * c) = o; }
    asm volatile("s_waitcnt lgkmcnt(0)" ::: "memory");
}
__device__ __forceinline__ void ph_convert_weights(Frame& F, const __attribute__((address_space(4))) Args* a, int l) {
    LAS float* scr = (LAS float*)(F.lds + F.wave * 8448);
    const int gw = blockIdx.x * NWAVES + F.wave, NGW = gridDim.x * NWAVES;
    constexpr int I_IN = (D / 64) * (NIN_ORIG / 32), I_SQ = (D / 64) * (D / 32), I_UP = (D / 64) * (NUP / 32), I_DN = (DFF / 64) * (D / 32);
    constexpr int NITEMS = I_IN + 3 * I_SQ + I_UP + I_DN;
    const float* w_in = (const float*)a->in[3] + (size_t)l * D * NIN_ORIG;
    const float* w_ba = (const float*)a->in[9] + (size_t)l * D * D;
    const float* w_bd = (const float*)a->in[10] + (size_t)l * D * D;
    const float* w_out = (const float*)a->in[11] + (size_t)l * D * D;
    const float* w_up = (const float*)a->in[14] + (size_t)l * D * NUP;
    const float* w_dn = (const float*)a->in[17] + (size_t)l * DFF * D;
    for (int it = gw; it < NITEMS; it += NGW) {
        int r = it;
        if (r < I_IN) { transpose_item(w_in, D, NIN_ORIG, (bf16_t*)(F.ws + WT_IN), scr, r, F.lane, 1); continue; } r -= I_IN;
        if (r < I_SQ) { transpose_item(w_ba, D, D, (bf16_t*)(F.ws + WT_BA), scr, r, F.lane, 0); continue; } r -= I_SQ;
        if (r < I_SQ) { transpose_item(w_bd, D, D, (bf16_t*)(F.ws + WT_BD), scr, r, F.lane, 0); continue; } r -= I_SQ;
        if (r < I_SQ) { transpose_item(w_out, D, D, (bf16_t*)(F.ws + WT_OUT), scr, r, F.lane, 0); continue; } r -= I_SQ;
        if (r < I_UP) { transpose_item(w_up, D, NUP, (bf16_t*)(F.ws + WT_UP), scr, r, F.lane, 2); continue; } r -= I_UP;
        transpose_item(w_dn, DFF, D, (bf16_t*)(F.ws + WT_DOWN), scr, r, F.lane, 0);
    }
    { u32x4* z = (u32x4*)(F.ws + WT_IN + (size_t)NIN_ORIG * D * 2); const int n16 = (NIN - NIN_ORIG) * D * 2 / 16;
      for (int i = blockIdx.x * NTHREADS + F.tid; i < n16; i += gridDim.x * NTHREADS) z[i] = (u32x4){0u, 0u, 0u, 0u}; }
}

__device__ const float INV_FREQ[16] = {1.000000000e+00f, 4.403665960e-01f, 1.939227432e-01f, 8.539710194e-02f, 3.760603070e-02f, 1.656043902e-02f, 7.292664610e-03f, 3.211445874e-03f,
                                       1.414213562e-03f, 6.227723788e-04f, 2.742481884e-04f, 1.207697351e-04f, 5.318296098e-05f, 2.341999971e-05f, 1.031338616e-05f, 4.541670478e-06f};
__device__ __forceinline__ void ph_rope_table(Frame& F) {
    float* rope = (float*)(F.ws + WS_ROPE);
    for (int idx = blockIdx.x * NTHREADS + F.tid; idx < T * 16; idx += gridDim.x * NTHREADS) {
        const int t = idx >> 4, i = idx & 15;
        const float angf = (float)F.pos[t] * INV_FREQ[i];
        const double ang = (double)angf;
        const double TWO_PI = 6.283185307179586476925;
        const double r = ang - rint(ang / TWO_PI) * TWO_PI;
        const double r2 = r * r;
        double c = 1.0, s = r, tc = 1.0, ts = r;
#pragma unroll
        for (int k = 1; k <= 14; ++k) { tc *= -r2 / (double)((2 * k - 1) * (2 * k)); c += tc; ts *= -r2 / (double)((2 * k) * (2 * k + 1)); s += ts; }
        rope[(size_t)t * 32 + i] = (float)c; rope[(size_t)t * 32 + 16 + i] = (float)s;
    }
}

__device__ __forceinline__ void ph_norm_first(Frame& F, const float* x, const float* w, bf16_t* xn) {
    const int gw = blockIdx.x * NWAVES + F.wave, NGW = gridDim.x * NWAVES;
    for (int row = gw; row < T; row += NGW) {
        const float* xr = x + (size_t)row * D + 8 * F.lane;
        f32x4 v[4][2]; float ss = 0.f;
#pragma unroll
        for (int j = 0; j < 4; ++j) { v[j][0] = *(const f32x4*)(xr + 512 * j); v[j][1] = *(const f32x4*)(xr + 512 * j + 4);
#pragma unroll
            for (int e = 0; e < 4; ++e) ss += v[j][0][e] * v[j][0][e] + v[j][1][e] * v[j][1][e]; }
        const float rstd = 1.0f / sqrtf(wave_sum(ss) * (1.0f / D) + EPS);
#pragma unroll
        for (int j = 0; j < 4; ++j) { const f32x4 w0 = *(const f32x4*)(w + 512 * j + 8 * F.lane), w1 = *(const f32x4*)(w + 512 * j + 8 * F.lane + 4);
            const f32x4 a0 = v[j][0] * rstd * w0, a1 = v[j][1] * rstd * w1;
            u32x4 o; o.x = pk2(a0[0], a0[1]); o.y = pk2(a0[2], a0[3]); o.z = pk2(a1[0], a1[1]); o.w = pk2(a1[2], a1[3]);
            *(u32x4*)(xn + (size_t)row * D + 512 * j + 8 * F.lane) = o; }
    }
}
template <bool BB, bool OB>
__device__ __forceinline__ void ph_norm_res(Frame& F, const bf16_t* src, const float* w1, const void* basev, void* outv, const float* w2, bf16_t* xn) {
    const int gw = blockIdx.x * NWAVES + F.wave, NGW = gridDim.x * NWAVES;
    for (int row0 = gw; row0 < T; row0 += 2 * NGW) {
        u32x4 sraw[2][4]; u32x4 braw[2][4]; f32x4 bf[2][4][2];
#pragma unroll
        for (int r = 0; r < 2; ++r) { const int row = row0 + r * NGW; const bool ok = row < T; const size_t ro = (size_t)(ok ? row : row0) * D + 8 * F.lane;
#pragma unroll
            for (int j = 0; j < 4; ++j) { sraw[r][j] = *(const u32x4*)(src + ro + 512 * j);
                if (BB) braw[r][j] = *(const u32x4*)((const bf16_t*)basev + ro + 512 * j);
                else { bf[r][j][0] = *(const f32x4*)((const float*)basev + ro + 512 * j); bf[r][j][1] = *(const f32x4*)((const float*)basev + ro + 512 * j + 4); } } }
#pragma unroll
        for (int r = 0; r < 2; ++r) { const int row = row0 + r * NGW; if (row >= T) break;
            const size_t ro = (size_t)row * D + 8 * F.lane;
            f32x4 v[4][2]; float ss = 0.f;
#pragma unroll
            for (int j = 0; j < 4; ++j) { const u32x4 s = sraw[r][j];
                v[j][0][0] = bf_lo(s.x); v[j][0][1] = bf_hi(s.x); v[j][0][2] = bf_lo(s.y); v[j][0][3] = bf_hi(s.y);
                v[j][1][0] = bf_lo(s.z); v[j][1][1] = bf_hi(s.z); v[j][1][2] = bf_lo(s.w); v[j][1][3] = bf_hi(s.w);
#pragma unroll
                for (int e = 0; e < 4; ++e) ss += v[j][0][e] * v[j][0][e] + v[j][1][e] * v[j][1][e]; }
            const float rstd = __builtin_amdgcn_rsqf(wave_sum(ss) * (1.0f / D) + EPS);
            float ss2 = 0.f;
#pragma unroll
            for (int j = 0; j < 4; ++j) { const f32x4 w0 = *(const f32x4*)(w1 + 512 * j + 8 * F.lane), w1v = *(const f32x4*)(w1 + 512 * j + 8 * F.lane + 4);
                f32x4 b0, b1;
                if (BB) { const u32x4 s = braw[r][j];
                    b0[0] = bf_lo(s.x); b0[1] = bf_hi(s.x); b0[2] = bf_lo(s.y); b0[3] = bf_hi(s.y); b1[0] = bf_lo(s.z); b1[1] = bf_hi(s.z); b1[2] = bf_lo(s.w); b1[3] = bf_hi(s.w); }
                else { b0 = bf[r][j][0]; b1 = bf[r][j][1]; }
                v[j][0] = b0 + v[j][0] * rstd * w0; v[j][1] = b1 + v[j][1] * rstd * w1v;
                if (OB) { u32x4 o; o.x = pk2(v[j][0][0], v[j][0][1]); o.y = pk2(v[j][0][2], v[j][0][3]); o.z = pk2(v[j][1][0], v[j][1][1]); o.w = pk2(v[j][1][2], v[j][1][3]); *(u32x4*)((bf16_t*)outv + ro + 512 * j) = o; }
                else { *(f32x4*)((float*)outv + ro + 512 * j) = v[j][0]; *(f32x4*)((float*)outv + ro + 512 * j + 4) = v[j][1]; }
#pragma unroll
                for (int e = 0; e < 4; ++e) ss2 += v[j][0][e] * v[j][0][e] + v[j][1][e] * v[j][1][e]; }
            if (w2) {
                const float rstd2 = __builtin_amdgcn_rsqf(wave_sum(ss2) * (1.0f / D) + EPS);
#pragma unroll
                for (int j = 0; j < 4; ++j) { const f32x4 w0 = *(const f32x4*)(w2 + 512 * j + 8 * F.lane), w1v = *(const f32x4*)(w2 + 512 * j + 8 * F.lane + 4);
                    const f32x4 a0 = v[j][0] * rstd2 * w0, a1 = v[j][1] * rstd2 * w1v;
                    u32x4 o; o.x = pk2(a0[0], a0[1]); o.y = pk2(a0[2], a0[3]); o.z = pk2(a1[0], a1[1]); o.w = pk2(a1[2], a1[3]);
                    *(u32x4*)(xn + ro + 512 * j) = o; }
            }
        }
    }
}

__device__ __forceinline__ void ph_ffn_fixup(Frame& F, const float* PART, const float* TAIL, const float* cw, bf16_t* ACT) {
    constexpr int NQ = DFF / 4;
    for (int idx = blockIdx.x * NTHREADS + F.tid; idx < (T / 64) * 2 * NQ; idx += gridDim.x * NTHREADS) {
        const int q = idx % NQ, br = idx / NQ, r = br & 1, band = br >> 1, ch = 4 * q;
        f32x4 g = *(const f32x4*)(PART + (size_t)br * 11264 + ch), v = *(const f32x4*)(PART + (size_t)br * 11264 + 5632 + ch);
        if ((band & 63) != 0) {
            const float* t0 = TAIL + (size_t)((band - 1) * 2) * 11264 + ch; const float* t1 = t0 + 11264;
            const f32x4 w0g = *(const f32x4*)(cw + ch), w1g = *(const f32x4*)(cw + 11264 + ch), w0v = *(const f32x4*)(cw + 5632 + ch), w1v = *(const f32x4*)(cw + 11264 + 5632 + ch);
            const f32x4 t1g = *(const f32x4*)t1, t1v = *(const f32x4*)(t1 + 5632);
            if (r == 0) { const f32x4 t0g = *(const f32x4*)t0, t0v = *(const f32x4*)(t0 + 5632); g += w0g * t0g + w1g * t1g; v += w0v * t0v + w1v * t1v; }
            else { g += w0g * t1g; v += w0v * t1v; }
        }
        u32x2 o; o.x = pk2(siluf_(g[0]) * v[0], siluf_(g[1]) * v[1]); o.y = pk2(siluf_(g[2]) * v[2], siluf_(g[3]) * v[3]);
        *(u32x2*)(ACT + (size_t)(band * 64 + r) * DFF + ch) = o;
    }
}

typedef short bf16x8_t __attribute__((ext_vector_type(8)));
typedef short s16x4_t __attribute__((ext_vector_type(4)));
typedef float f32x16_t __attribute__((ext_vector_type(16)));
#define MFMA32(a, b, c) __builtin_amdgcn_mfma_f32_32x32x16_bf16((a), (b), (c), 0, 0, 0)
__device__ __forceinline__ s16x4_t lds_tr16(LAS unsigned char* p) { typedef short v4i16_t __attribute__((ext_vector_type(4))); return __builtin_bit_cast(s16x4_t, __builtin_amdgcn_ds_read_tr16_b64_v4i16((LAS v4i16_t*)p)); }
__device__ __forceinline__ void ph_attn(Frame& F, const bf16_t* QA, bf16_t* OA, const bf16_t* KA, const bf16_t* VA, const float* sinks, int first, int stride, int last) {
    LAS unsigned char* Ks = F.lds; LAS unsigned char* Vs = F.lds + 65536;
    const int lane = F.lane, w = F.wave, r = lane & 31, h = lane >> 5;
    const int vlane = ((4 * h + ((lane & 15) >> 2)) * 256) + (16 * ((lane >> 4) & 1) + 4 * (lane & 3)) * 2;
    for (int it = first; it < last; it += stride) {
        const int kvh = it & 3, blk = (it >> 2) & 31, b = it >> 7;
        const int t0 = b * SEQ + blk * 128;
        const int tk0 = (blk > 0) ? t0 - 128 : t0;
#pragma unroll
        for (int j = 0; j < 8; ++j) { const int cid = F.tid + 512 * j, key = cid >> 4, c16 = cid & 15;
            const int tok = (key < 128) ? tk0 + key : t0 + key - 128;
            const u32x4 kv = *(const u32x4*)(KA + (size_t)tok * 512 + kvh * 128 + c16 * 8), vv = *(const u32x4*)(VA + (size_t)tok * 512 + kvh * 128 + c16 * 8);
            *(LAS u32x4*)(Ks + key * 256 + ((c16 ^ (key & 15)) << 4)) = kv; *(LAS u32x4*)(Vs + key * 256 + c16 * 16) = vv; }
        LDS_BARRIER();
        const int hd = kvh * 4 + (w >> 1);
        const float sink = sinks[hd];
#pragma unroll 1
        for (int si = 0; si < 2; ++si) {
            const int s = 2 * (w & 1) + si;
            const bf16_t* qrow = QA + (size_t)(t0 + 32 * s + r) * 2048 + hd * 128; bf16_t* orow = OA + (size_t)(t0 + 32 * s + r) * 2048 + hd * 128;
            bf16x8_t qf[8];
#pragma unroll
            for (int ks = 0; ks < 8; ++ks) qf[ks] = *(const bf16x8_t*)(qrow + 16 * ks + 8 * h);
            f32x16_t S[5];
#pragma unroll
            for (int ct = 0; ct < 5; ++ct) { f32x16_t acc;
#pragma unroll
                for (int i = 0; i < 16; ++i) acc[i] = 0.f;
                const int key = 32 * (s + ct) + r;
#pragma unroll
                for (int ks = 0; ks < 8; ++ks) { const bf16x8_t kf = *(const LAS bf16x8_t*)(Ks + key * 256 + (((2 * ks + h) ^ (key & 15)) << 4)); acc = MFMA32(kf, qf[ks], acc); }
                S[ct] = acc; }
            const int qi = 32 * s + r;
            float mx = -__builtin_inff();
#pragma unroll
            for (int ct = 0; ct < 5; ++ct)
#pragma unroll
                for (int i = 0; i < 16; ++i) { const int c = 32 * (s + ct) + (i & 3) + 8 * (i >> 2) + 4 * h;
                    const bool valid = (c > qi) && (c <= qi + 128) && (blk > 0 || c >= 128);
                    const float v = valid ? S[ct][i] * 0.08838834764831845f : -__builtin_inff(); S[ct][i] = v; mx = fmaxf(mx, v); }
            mx = fmaxf(mx, __shfl_xor(mx, 32));
            const float m = fmaxf(mx, sink);
            float sum = 0.f;
#pragma unroll
            for (int ct = 0; ct < 5; ++ct)
#pragma unroll
                for (int i = 0; i < 16; ++i) { const float p = __expf(S[ct][i] - m); S[ct][i] = p; sum += p; }
            sum += __shfl_xor(sum, 32);
            const float inv = 1.0f / (sum + __expf(sink - m));
            f32x16_t O[4];
#pragma unroll
            for (int dt = 0; dt < 4; ++dt)
#pragma unroll
                for (int i = 0; i < 16; ++i) O[dt][i] = 0.f;
#pragma unroll
            for (int ct = 0; ct < 5; ++ct)
#pragma unroll
                for (int s2 = 0; s2 < 2; ++s2) {
                    u32x4 pw; pw.x = pk2(S[ct][8 * s2 + 0], S[ct][8 * s2 + 1]); pw.y = pk2(S[ct][8 * s2 + 2], S[ct][8 * s2 + 3]); pw.z = pk2(S[ct][8 * s2 + 4], S[ct][8 * s2 + 5]); pw.w = pk2(S[ct][8 * s2 + 6], S[ct][8 * s2 + 7]);
                    const bf16x8_t pf = __builtin_bit_cast(bf16x8_t, pw);
                    LAS unsigned char* vb = Vs + vlane + (32 * (s + ct) + 16 * s2) * 256;
#pragma unroll
                    for (int dt = 0; dt < 4; ++dt) { const s16x4_t va = lds_tr16(vb + dt * 64), vc = lds_tr16(vb + dt * 64 + 2048);
                        const bf16x8_t vf = __builtin_shufflevector(va, vc, 0, 1, 2, 3, 4, 5, 6, 7);
                        O[dt] = MFMA32(vf, pf, O[dt]); }
                }
#pragma unroll
            for (int dt = 0; dt < 4; ++dt)
#pragma unroll
                for (int gq = 0; gq < 4; ++gq) { u32x2 o; o.x = pk2(O[dt][4 * gq] * inv, O[dt][4 * gq + 1] * inv); o.y = pk2(O[dt][4 * gq + 2] * inv, O[dt][4 * gq + 3] * inv);
                    *(u32x2*)(orow + 32 * dt + 8 * gq + 4 * h) = o; }
        }
        LDS_BARRIER();
    }
}

#ifndef DUP_S1
#define DUP_S1 1
#endif
#ifndef DUP_S2
#define DUP_S2 1
#endif
#ifndef DUP_S3
#define DUP_S3 1
#endif
#ifndef DUP_S5
#define DUP_S5 1
#endif
#ifndef DUP_SOLVE
#define DUP_SOLVE 0
#endif
constexpr int DR_W = 0, DR_QG = 16384, DR_KG = 32768, DR_QK = 49152, DR_DL = 55296, DR_U = 55552, DR_BYTES = 72192;
#ifndef SCAN_AUX
#define SCAN_AUX 0
#endif
constexpr int DN_LBUF = 57344;
#define MFMA16(a, b, c) __builtin_amdgcn_mfma_f32_16x16x32_bf16((a), (b), (c), 0, 0, 0)
__device__ __forceinline__ int tsw(int row, int col) { return row * 272 + col * 2; }
__device__ __forceinline__ bf16_t bf16r(float v) { return (bf16_t)(pk2(v, 0.f) & 0xffffu); }
__device__ __forceinline__ void unpack8(const u32x4 w, float* o) { o[0] = bf_lo(w.x); o[1] = bf_hi(w.x); o[2] = bf_lo(w.y); o[3] = bf_hi(w.y); o[4] = bf_lo(w.z); o[5] = bf_hi(w.z); o[6] = bf_lo(w.w); o[7] = bf_hi(w.w); }
__device__ __forceinline__ bf16x8_t packstep(const f32x16_t& X, const int s) { u32x4 p; p.x = pk2(X[8 * s], X[8 * s + 1]); p.y = pk2(X[8 * s + 2], X[8 * s + 3]); p.z = pk2(X[8 * s + 4], X[8 * s + 5]); p.w = pk2(X[8 * s + 6], X[8 * s + 7]); return __builtin_bit_cast(bf16x8_t, p); }

__device__ __forceinline__ bf16x8_t mk_b(const f32x4 p, const f32x4 q) { u32x4 w; w.x = pk2(p[0], p[1]); w.y = pk2(p[2], p[3]); w.z = pk2(q[0], q[1]); w.w = pk2(q[2], q[3]); return __builtin_bit_cast(bf16x8_t, w); }
__device__ __forceinline__ bf16x8_t mk_a(const u32x2 p, const u32x2 q) { u32x4 w; w.x = p.x; w.y = p.y; w.z = q.x; w.w = q.y; return __builtin_bit_cast(bf16x8_t, w); }
__device__ __forceinline__ void ph_dn_prep(Frame& F, const bf16_t* QKVD, const float* BAf, const float* convw, const float* a_log, const float* dt_bias, unsigned char* DN) {
    const int hb = F.tid >> 8, lw = (F.tid >> 6) & 3, lane = F.lane;
    int ltid = F.tid & 255;
#define DN_LAUNDER() asm volatile("" : "+v"(ltid))
    LAS unsigned char* HB = F.lds + hb * 75776;
    LAS unsigned char* QH = HB; LAS unsigned char* KH = HB + 17408; LAS unsigned char* VH = HB + 34816;
    LAS float* AD = (LAS float*)(HB + 52224);
    LAS unsigned char* ABF = HB + 56320;
    LAS unsigned char* QKS = HB + 64512;
    LAS unsigned char* TIB = HB + 72704;
    LAS float* SC = (LAS float*)(HB + 74752);
    volatile LAS unsigned* hcnt = (volatile LAS unsigned*)(F.lds + MISC_OFF + 64 + 64 * hb);
    if (ltid == 0) *hcnt = 0u;
    LDS_BARRIER();
#define HALF_BARRIER() do { asm volatile("s_waitcnt lgkmcnt(0)" ::: "memory"); unsigned old_ = 0u; \
        if (lane == 0) old_ = __hip_atomic_fetch_add((LAS unsigned*)hcnt, 1u, __ATOMIC_RELAXED, __HIP_MEMORY_SCOPE_WORKGROUP); \
        const unsigned tgt_ = ((unsigned)__builtin_amdgcn_readfirstlane((int)old_) & ~3u) + 4u; unsigned sp_ = 0u; \
        while ((unsigned)__builtin_amdgcn_readfirstlane((int)*hcnt) < tgt_) { __builtin_amdgcn_s_sleep(1); if (++sp_ > (1u << 22)) break; } \
        asm volatile("" ::: "memory"); } while (0)
    u32x4 xr[3][7];
#define DN_LOADRAW(IT) do { const int hp_ = (IT) & 7, cidx_ = (IT) >> 3, h_ = 2 * hp_ + hb, n_ = cidx_ & 63; const int cg_ = ltid & 15, rs_ = ltid >> 4; \
        _Pragma("unroll") for (int sec_ = 0; sec_ < 3; ++sec_) { const int col_ = sec_ * 2048 + h_ * 128 + 8 * cg_; \
            _Pragma("unroll") for (int k_ = 0; k_ < 7; ++k_) { const int rloc_ = 4 * rs_ - 3 + k_; \
                if (n_ * 64 + rloc_ >= 0) xr[sec_][k_] = *(const u32x4*)(QKVD + (size_t)(cidx_ * 64 + rloc_) * 6144 + col_); else xr[sec_][k_] = (u32x4){0u, 0u, 0u, 0u}; } } } while (0)
    for (int it = blockIdx.x; it < NB * 64 * 8; it += gridDim.x) {
        const int hp = it & 7, cidx = it >> 3, h = 2 * hp + hb, b = cidx >> 6, n = cidx & 63;
        const int tb = cidx * 64;
        unsigned char* rec = DN + (size_t)((b * 16 + h) * 64 + n) * DR_BYTES;
        DN_LAUNDER();
        DN_LOADRAW(it);
        { const int cg = ltid & 15, rs = ltid >> 4;
#pragma unroll
          for (int sec = 0; sec < 3; ++sec) {
              const int col = sec * 2048 + h * 128 + 8 * cg;
              float wv[4][8];
#pragma unroll
              for (int j = 0; j < 4; ++j) { const f32x4 a0 = *(const f32x4*)(convw + j * 6144 + col), a1 = *(const f32x4*)(convw + j * 6144 + col + 4);
#pragma unroll
                  for (int e = 0; e < 4; ++e) { wv[j][e] = a0[e]; wv[j][4 + e] = a1[e]; } }
              LAS unsigned char* tile = (sec == 0) ? QH : ((sec == 1) ? KH : VH);
#pragma unroll
              for (int rr = 0; rr < 4; ++rr) { float o[8]; float ss = 0.f; float x0[8], x1[8], x2[8], x3[8]; unpack8(xr[sec][rr], x0); unpack8(xr[sec][rr + 1], x1); unpack8(xr[sec][rr + 2], x2); unpack8(xr[sec][rr + 3], x3);
#pragma unroll
                  for (int e = 0; e < 8; ++e) { const float a = wv[0][e] * x0[e] + wv[1][e] * x1[e] + wv[2][e] * x2[e] + wv[3][e] * x3[e]; o[e] = siluf_(a); ss += o[e] * o[e]; }
                  if (sec < 2) { ss += __shfl_xor(ss, 1); ss += __shfl_xor(ss, 2); ss += __shfl_xor(ss, 4); ss += __shfl_xor(ss, 8);
                      const float sc = __builtin_amdgcn_rsqf(ss + 1e-6f) * ((sec == 0) ? 0.08838834764831845f : 1.0f);
#pragma unroll
                      for (int e = 0; e < 8; ++e) o[e] *= sc; }
                  u32x4 pw; pw.x = pk2(o[0], o[1]); pw.y = pk2(o[2], o[3]); pw.z = pk2(o[4], o[5]); pw.w = pk2(o[6], o[7]);
                  *(LAS u32x4*)(tile + tsw(4 * rs + rr, 8 * cg)) = pw; }
              __builtin_amdgcn_sched_barrier(0);
          } }
        if (lw == 0) { const int i = lane; const size_t tok = (size_t)tb + i;
            const float bd = BAf[tok * 32 + h], ad = BAf[tok * 32 + 16 + h];
            const float xs = ad + dt_bias[h]; const float sp = (xs > 20.f) ? xs : log1pf(__expf(xs));
            float gc = -__expf(a_log[h]) * sp;
            int ln = lane; asm volatile("" : "+v"(ln));
#pragma unroll
            for (int o = 1; o < 64; o <<= 1) { const int src = (ln >= o) ? ln - o : ln; const float t = __builtin_bit_cast(float, __builtin_amdgcn_ds_bpermute(src << 2, __builtin_bit_cast(int, gc))); if (ln >= o) gc += t; }
            const float gl = __builtin_bit_cast(float, __builtin_amdgcn_readlane(__builtin_bit_cast(int, gc), 63));
            SC[i] = sigmoidf_(bd); SC[64 + i] = gc; SC[128 + i] = __expf(gc); SC[192 + i] = __expf(gl - gc);
            if (lane == 0) *(float*)(rec + DR_DL) = __expf(gl); }
        HALF_BARRIER();
        { const int I = lw, fr = lane & 15, fq = lane >> 4;
          bf16x8_t ak[4], aq[4];
#pragma unroll
          for (int ks = 0; ks < 4; ++ks) { ak[ks] = *(const LAS bf16x8_t*)(KH + tsw(16 * I + fr, 32 * ks + 8 * fq)); aq[ks] = *(const LAS bf16x8_t*)(QH + tsw(16 * I + fr, 32 * ks + 8 * fq)); }
          float gci[4], bti[4];
#pragma unroll
          for (int q = 0; q < 4; ++q) { gci[q] = SC[64 + 16 * I + 4 * fq + q]; bti[q] = SC[16 * I + 4 * fq + q]; }
#pragma unroll
          for (int J = 0; J < 4; ++J) { f32x4 ckk = {0.f, 0.f, 0.f, 0.f}, cqk = ckk;
#pragma unroll
              for (int ks = 0; ks < 4; ++ks) { const bf16x8_t bfr = *(const LAS bf16x8_t*)(KH + tsw(16 * J + fr, 32 * ks + 8 * fq)); ckk = MFMA16(ak[ks], bfr, ckk); cqk = MFMA16(aq[ks], bfr, cqk); }
              const int j = 16 * J + fr; const float gcj = SC[64 + j];
#pragma unroll
              for (int q = 0; q < 4; ++q) { const int i = 16 * I + 4 * fq + q; const float ex = __expf(fminf(gci[q] - gcj, 0.f));
                  const float av = (j < i) ? bti[q] * ckk[q] * ex : 0.f;
                  *(LAS bf16_t*)(ABF + (i * 64 + j) * 2) = bf16r(-av);
                  if (J == I) AD[I * 256 + (4 * fq + q) * 16 + fr] = av;
                  *(LAS bf16_t*)(QKS + (i * 64 + j) * 2) = bf16r((j <= i) ? cqk[q] * ex : 0.f); } } }
        HALF_BARRIER();
        DN_LAUNDER();
#pragma unroll
        for (int q4 = 0; q4 < 4; ++q4) { const int p = ltid + 256 * q4, mk = p >> 6, lp = p & 63, hh = lp >> 5, rr = lp & 31, mt = mk >> 3, ks = mk & 7, row = 32 * mt + rr;
            const u32x2 a = *(const LAS u32x2*)(QH + tsw(row, 16 * ks + 4 * hh)), b2 = *(const LAS u32x2*)(QH + tsw(row, 16 * ks + 8 + 4 * hh));
            const float sc = SC[128 + row];
            u32x4 o; o.x = pk2(bf_lo(a.x) * sc, bf_hi(a.x) * sc); o.y = pk2(bf_lo(a.y) * sc, bf_hi(a.y) * sc); o.z = pk2(bf_lo(b2.x) * sc, bf_hi(b2.x) * sc); o.w = pk2(bf_lo(b2.y) * sc, bf_hi(b2.y) * sc);
            __builtin_nontemporal_store(o, (u32x4*)(rec + DR_QG + p * 16)); }
#pragma unroll
        for (int q4 = 0; q4 < 4; ++q4) { const int p = ltid + 256 * q4, mk = p >> 6, lp = p & 63, hh = lp >> 5, rr = lp & 31, mt = mk >> 2, ks = mk & 3, d = 32 * mt + rr;
            float v[8];
#pragma unroll
            for (int j = 0; j < 8; ++j) { const int cc = 16 * ks + 8 * (j >> 2) + 4 * hh + (j & 3); v[j] = bf1(*(const LAS bf16_t*)(KH + tsw(cc, d))) * SC[192 + cc]; }
            u32x4 o; o.x = pk2(v[0], v[1]); o.y = pk2(v[2], v[3]); o.z = pk2(v[4], v[5]); o.w = pk2(v[6], v[7]);
            __builtin_nontemporal_store(o, (u32x4*)(rec + DR_KG + p * 16)); }
#pragma unroll
        for (int q2 = 0; q2 < 2; ++q2) { const int p = ltid + 256 * q2, mk = p >> 6, lp = p & 63, hh = lp >> 5, rr = lp & 31, mt = mk >> 2, ks = mk & 3, i = 32 * mt + rr;
            if (mt == 0 && ks >= 2) continue;
            const u32x2 a = *(const LAS u32x2*)(QKS + (i * 64 + 16 * ks + 4 * hh) * 2), b2 = *(const LAS u32x2*)(QKS + (i * 64 + 16 * ks + 8 + 4 * hh) * 2);
            u32x4 o; o.x = a.x; o.y = a.y; o.z = b2.x; o.w = b2.y;
            __builtin_nontemporal_store(o, (u32x4*)(rec + DR_QK + ((mt == 0 ? ks : 2 + ks) * 64 + lp) * 16)); }
        if (lw == 0) { const int I = lane >> 4, cc = lane & 15; const LAS float* ad = AD + I * 256;
            float t[16];
#pragma unroll
            for (int i = 0; i < 16; ++i) { float s = 0.f;
#pragma unroll
                for (int j = 0; j < i; ++j) s += ad[i * 16 + j] * t[j];
                t[i] = ((i == cc) ? 1.f : 0.f) - s; }
#pragma unroll
            for (int m = 0; m < 16; ++m) *(LAS bf16_t*)(TIB + ((I * 16 + m) * 16 + cc) * 2) = bf16r(t[m]); }
        HALF_BARRIER();
        DN_LAUNDER();
        { const int fr = lane & 15, fq = lane >> 4;
          const u32x2 z2 = {0u, 0u}; const f32x4 z4 = {0.f, 0.f, 0.f, 0.f};
          bf16x8_t aT[4], a10, a2x, a3x, a32;
#pragma unroll
          for (int I = 0; I < 4; ++I) aT[I] = mk_a(*(const LAS u32x2*)(TIB + ((I * 16 + fr) * 16 + 4 * fq) * 2), z2);
          a10 = mk_a(*(const LAS u32x2*)(ABF + ((16 + fr) * 64 + 4 * fq) * 2), z2);
          a2x = mk_a(*(const LAS u32x2*)(ABF + ((32 + fr) * 64 + 4 * fq) * 2), *(const LAS u32x2*)(ABF + ((32 + fr) * 64 + 16 + 4 * fq) * 2));
          a3x = mk_a(*(const LAS u32x2*)(ABF + ((48 + fr) * 64 + 4 * fq) * 2), *(const LAS u32x2*)(ABF + ((48 + fr) * 64 + 16 + 4 * fq) * 2));
          a32 = mk_a(*(const LAS u32x2*)(ABF + ((48 + fr) * 64 + 32 + 4 * fq) * 2), z2);
          float bt[4][4], eg[4][4];
#pragma unroll
          for (int I = 0; I < 4; ++I)
#pragma unroll
              for (int q = 0; q < 4; ++q) { bt[I][q] = SC[16 * I + 4 * fq + q]; eg[I][q] = SC[128 + 16 * I + 4 * fq + q]; }
#pragma unroll 1
          for (int pass = 0; pass < 2; ++pass) {
#pragma unroll
              for (int tt = 0; tt < 2; ++tt) { const int col = 16 * (2 * lw + tt) + fr;
                  f32x4 R[4];
#pragma unroll
                  for (int I = 0; I < 4; ++I)
#pragma unroll
                      for (int q = 0; q < 4; ++q) { const int row = 16 * I + 4 * fq + q;
                          R[I][q] = (pass == 0) ? -bf1(*(const LAS bf16_t*)(KH + tsw(row, col))) * bt[I][q] * eg[I][q] : bf1(*(const LAS bf16_t*)(VH + tsw(row, col))) * bt[I][q]; }
                  const f32x4 X0 = MFMA16(aT[0], mk_b(R[0], z4), z4);
                  const f32x4 E1 = MFMA16(a10, mk_b(X0, z4), R[1]);
                  const f32x4 X1 = MFMA16(aT[1], mk_b(E1, z4), z4);
                  const f32x4 E2 = MFMA16(a2x, mk_b(X0, X1), R[2]);
                  const f32x4 X2 = MFMA16(aT[2], mk_b(E2, z4), z4);
                  f32x4 E3 = MFMA16(a3x, mk_b(X0, X1), R[3]);
                  E3 = MFMA16(a32, mk_b(X2, z4), E3);
                  const f32x4 X3 = MFMA16(aT[3], mk_b(E3, z4), z4);
                  if (pass == 0) {
#pragma unroll
                      for (int q = 0; q < 4; ++q) { *(LAS bf16_t*)(QH + tsw(4 * fq + q, col)) = bf16r(X0[q]); *(LAS bf16_t*)(QH + tsw(16 + 4 * fq + q, col)) = bf16r(X1[q]);
                          *(LAS bf16_t*)(QH + tsw(32 + 4 * fq + q, col)) = bf16r(X2[q]); *(LAS bf16_t*)(QH + tsw(48 + 4 * fq + q, col)) = bf16r(X3[q]); }
                  } else {
                      u32x2 o; o.x = pk2(X0[0], X0[1]); o.y = pk2(X0[2], X0[3]); *(LAS u32x2*)(KH + col * 128 + (4 * fq) * 2) = o;
                      o.x = pk2(X1[0], X1[1]); o.y = pk2(X1[2], X1[3]); *(LAS u32x2*)(KH + col * 128 + (16 + 4 * fq) * 2) = o;
                      o.x = pk2(X2[0], X2[1]); o.y = pk2(X2[2], X2[3]); *(LAS u32x2*)(KH + col * 128 + (32 + 4 * fq) * 2) = o;
                      o.x = pk2(X3[0], X3[1]); o.y = pk2(X3[2], X3[3]); *(LAS u32x2*)(KH + col * 128 + (48 + 4 * fq) * 2) = o; }
              }
              if (pass == 0) HALF_BARRIER();
          } }
        HALF_BARRIER();
        DN_LAUNDER();
#pragma unroll
        for (int q4 = 0; q4 < 4; ++q4) { const int p = ltid + 256 * q4, mk = p >> 6, lp = p & 63, hh = lp >> 5, rr = lp & 31, mt = mk >> 3, ks = mk & 7, row = 32 * mt + rr;
            const u32x2 a = *(const LAS u32x2*)(QH + tsw(row, 16 * ks + 4 * hh)), b2 = *(const LAS u32x2*)(QH + tsw(row, 16 * ks + 8 + 4 * hh));
            u32x4 o; o.x = a.x; o.y = a.y; o.z = b2.x; o.w = b2.y;
            __builtin_nontemporal_store(o, (u32x4*)(rec + DR_W + p * 16)); }
#pragma unroll
        for (int q2 = 0; q2 < 2; ++q2) { const int p = ltid + 256 * q2, mk = p >> 6, lp = p & 63, hh = lp >> 5, rr = lp & 31, ct = mk >> 2, et = mk & 3, e = 32 * et + rr;
            u32x2 g[4];
#pragma unroll
            for (int gq = 0; gq < 4; ++gq) g[gq] = *(const LAS u32x2*)(KH + e * 128 + (32 * ct + 8 * gq + 4 * hh) * 2);
            u32x4 o0, o1; o0.x = g[0].x; o0.y = g[0].y; o0.z = g[1].x; o0.w = g[1].y; o1.x = g[2].x; o1.y = g[2].y; o1.z = g[3].x; o1.w = g[3].y;
            __builtin_nontemporal_store(o0, (u32x4*)(rec + DR_U + p * 32)); __builtin_nontemporal_store(o1, (u32x4*)(rec + DR_U + p * 32 + 16)); }
        HALF_BARRIER();
    }
    LDS_BARRIER();
#undef DN_LAUNDER
#undef HALF_BARRIER
#undef DN_LOADRAW
}

__device__ __forceinline__ void dn_epilogue(int t2, LAS unsigned char* Ob  , const u32x4 (&zr)[4], const LAS float* nwl  , bf16_t* OD, int tok0, int h) {
    const int c = t2 >> 2, cq = t2 & 3;
    float ss = 0.f;
#pragma unroll
    for (int k = 0; k < 4; ++k) { float t[8]; unpack8(*(const LAS u32x4*)(Ob + (c * 128 + 32 * cq + 8 * k) * 2), t);
#pragma unroll
        for (int e = 0; e < 8; ++e) ss += t[e] * t[e]; }
    asm volatile("" ::: "memory");
    ss += __shfl_xor(ss, 1); ss += __shfl_xor(ss, 2);
    const float rstd = __builtin_amdgcn_rsqf(ss * (1.0f / 128.f) + EPS);
    bf16_t* op = OD + (size_t)(tok0 + c) * 2048 + h * 128 + 32 * cq;
#pragma unroll
    for (int k2 = 0; k2 < 4; ++k2) { float z[8], ov[8]; unpack8(zr[k2], z); unpack8(*(const LAS u32x4*)(Ob + (c * 128 + 32 * cq + 8 * k2) * 2), ov);
        float y[8];
        const f32x4 n0 = *(const LAS f32x4*)(nwl + 32 * cq + 8 * k2), n1 = *(const LAS f32x4*)(nwl + 32 * cq + 8 * k2 + 4);
#pragma unroll
        for (int e = 0; e < 4; ++e) { y[e] = ov[e] * rstd * n0[e] * siluf_(z[e]); y[4 + e] = ov[4 + e] * rstd * n1[e] * siluf_(z[4 + e]); }
        u32x4 o; o.x = pk2(y[0], y[1]); o.y = pk2(y[2], y[3]); o.z = pk2(y[4], y[5]); o.w = pk2(y[6], y[7]);
        *(u32x4*)(op + 8 * k2) = o; }
}
__device__ __forceinline__ void ph_dn_scan(Frame& F, int it, const bf16_t* ZD, bf16_t* OD, const float* norm_w, const unsigned char* DN) {
    const int b = it >> 4, h = it & 15, lane = F.lane, w = F.wave;
    const unsigned char* recs = DN + (size_t)((b * 16 + h) * 64) * DR_BYTES;
    const __amdgpu_buffer_rsrc_t rsrc = __builtin_amdgcn_make_buffer_rsrc((void*)recs, 0, 64 * DR_BYTES, 0x00020000);
#define BLD16(voff, soff) __builtin_bit_cast(u32x4, __builtin_amdgcn_raw_buffer_load_b128(rsrc, (voff), (soff), SCAN_AUX))
    LAS unsigned char* Ob = F.lds + 2 * DN_LBUF;
    if (w < 4) {
        f32x16_t S[4];
#pragma unroll
        for (int dt = 0; dt < 4; ++dt)
#pragma unroll
            for (int i = 0; i < 16; ++i) S[dt][i] = 0.f;
        u32x4 uA[2][2], uB[2][2];
#pragma unroll
        for (int ct = 0; ct < 2; ++ct) { uA[ct][0] = BLD16(lane * 32, DR_U + (ct * 4 + w) * 2048); uA[ct][1] = BLD16(lane * 32 + 16, DR_U + (ct * 4 + w) * 2048);
            uB[ct][0] = BLD16(lane * 32, DR_BYTES + DR_U + (ct * 4 + w) * 2048); uB[ct][1] = BLD16(lane * 32 + 16, DR_BYTES + DR_U + (ct * 4 + w) * 2048); }
        LDS_BARRIER();
#define SC_CHUNK(n, UU) do { \
            int lv = lane; asm volatile("" : "+v"(lv));     \
            LAS unsigned char* buf = F.lds + ((n) & 1) * DN_LBUF; \
            const float dl = *(const LAS float*)(buf + DR_DL); \
            f32x16_t v[2], o[2]; \
            _Pragma("unroll") for (int ct = 0; ct < 2; ++ct) { float t0[8], t1[8]; unpack8(UU[ct][0], t0); unpack8(UU[ct][1], t1); \
                _Pragma("unroll") for (int i = 0; i < 8; ++i) { v[ct][i] = t0[i]; v[ct][8 + i] = t1[i]; o[ct][i] = 0.f; o[ct][8 + i] = 0.f; } } \
            if ((n) + 2 < 64) {                              \
                _Pragma("unroll") for (int ct = 0; ct < 2; ++ct) { UU[ct][0] = BLD16(lv * 32, ((n) + 2) * DR_BYTES + DR_U + (ct * 4 + w) * 2048); UU[ct][1] = BLD16(lv * 32 + 16, ((n) + 2) * DR_BYTES + DR_U + (ct * 4 + w) * 2048); } } \
              \
            bf16x8_t fa[2][4], fb[2][3]; \
            SC_LDA(0); \
            _Pragma("unroll") for (int ks = 0; ks < 8; ++ks) {                 \
                if (ks + 1 < 8) SC_LDA(ks + 1); else SC_LDB(0, 0); \
                __builtin_amdgcn_sched_barrier(0); \
                const bf16x8_t sp = packstep(S[ks >> 1], ks & 1); \
                _Pragma("unroll") for (int ct = 0; ct < 2; ++ct) { v[ct] = MFMA32(fa[ks & 1][2 * ct], sp, v[ct]); o[ct] = MFMA32(fa[ks & 1][2 * ct + 1], sp, o[ct]); } \
                __builtin_amdgcn_sched_barrier(0); } \
            _Pragma("unroll") for (int dt = 0; dt < 4; ++dt) _Pragma("unroll") for (int i = 0; i < 16; ++i) S[dt][i] *= dl; \
            _Pragma("unroll") for (int k2 = 0; k2 < 4; ++k2) {                 \
                const bf16x8_t vp = packstep(v[k2 >> 1], k2 & 1); \
                SC_LDB(k2, 1); \
                __builtin_amdgcn_sched_barrier(0); \
                if (k2 < 2) o[0] = MFMA32(fb[0][0], vp, o[0]);                \
                o[1] = MFMA32(fb[0][1], vp, o[1]); S[0] = MFMA32(fb[0][2], vp, S[0]); \
                __builtin_amdgcn_sched_barrier(0); \
                if (k2 + 1 < 4) SC_LDB(k2 + 1, 0); \
                __builtin_amdgcn_sched_barrier(0); \
                S[1] = MFMA32(fb[1][0], vp, S[1]); S[2] = MFMA32(fb[1][1], vp, S[2]); S[3] = MFMA32(fb[1][2], vp, S[3]); \
                __builtin_amdgcn_sched_barrier(0); } \
            { LAS unsigned char* ob = Ob + ((n) & 1) * 16384; \
              _Pragma("unroll") for (int ct = 0; ct < 2; ++ct) _Pragma("unroll") for (int i = 0; i < 16; ++i) \
                  *(LAS bf16_t*)(ob + ((32 * ct + (i & 3) + 8 * (i >> 2) + 4 * (lv >> 5)) * 128 + 32 * w + (lv & 31)) * 2) = bf16r(o[ct][i]); } \
            LDS_BARRIER();                                  \
        } while (0)
#define SC_LDA(ks) do { _Pragma("unroll") for (int ct_ = 0; ct_ < 2; ++ct_) { fa[(ks) & 1][2 * ct_] = *(const LAS bf16x8_t*)(buf + DR_W + ((ct_ * 8 + (ks)) * 64 + lv) * 16); fa[(ks) & 1][2 * ct_ + 1] = *(const LAS bf16x8_t*)(buf + DR_QG + ((ct_ * 8 + (ks)) * 64 + lv) * 16); } } while (0)
#define SC_LDB(k2, hf) do { if ((hf) == 0) { if ((k2) < 2) fb[0][0] = *(const LAS bf16x8_t*)(buf + DR_QK + ((k2) * 64 + lv) * 16); fb[0][1] = *(const LAS bf16x8_t*)(buf + DR_QK + ((2 + (k2)) * 64 + lv) * 16); \
                fb[0][2] = *(const LAS bf16x8_t*)(buf + DR_KG + ((0 * 4 + (k2)) * 64 + lv) * 16); } \
            else { _Pragma("unroll") for (int dt_ = 1; dt_ < 4; ++dt_) fb[1][dt_ - 1] = *(const LAS bf16x8_t*)(buf + DR_KG + ((dt_ * 4 + (k2)) * 64 + lv) * 16); } } while (0)
#pragma unroll 1
        for (int n = 0; n < 64; n += 2) { SC_CHUNK(n, uA); SC_CHUNK(n + 1, uB); }
#undef SC_CHUNK
#undef SC_LDA
#undef SC_LDB
        LDS_BARRIER();
    } else {
        const int t2 = F.tid - 256, sg = t2 >> 7, tg = t2 & 127;
        u32x4 stg[28];
        if (sg == 0) {
#pragma unroll
            for (int k = 0; k < 28; ++k) stg[k] = BLD16(tg * 16, 2048 * k);
#pragma unroll
            for (int k = 0; k < 28; ++k) *(LAS u32x4*)(F.lds + (tg + 128 * k) * 16) = stg[k];
            asm volatile("s_waitcnt lgkmcnt(0)" ::: "memory"); __builtin_amdgcn_sched_barrier(0);
#pragma unroll
            for (int k = 0; k < 28; ++k) stg[k] = BLD16(tg * 16, 2 * DR_BYTES + 2048 * k);
        } else {
#pragma unroll
            for (int k = 0; k < 28; ++k) stg[k] = BLD16(tg * 16, DR_BYTES + 2048 * k);
        }
        LAS float* nwl = (LAS float*)(F.lds + 2 * DN_LBUF + 32768);
        if (t2 < 32) *(LAS f32x4*)(nwl + 4 * t2) = *(const f32x4*)(norm_w + 4 * t2);
        LDS_BARRIER();
#define SC_STAGE(n, GRP) do { \
            int t2v = t2; asm volatile("" : "+v"(t2v));     \
            u32x4 zr[4];                                     \
            { const bf16_t* zp_ = ZD + (size_t)(b * SEQ + ((n) > 0 ? (n) - 1 : 0) * 64 + (t2v >> 2)) * 2048 + h * 128 + 32 * (t2v & 3); \
              _Pragma("unroll") for (int k = 0; k < 4; ++k) zr[k] = *(const u32x4*)(zp_ + 8 * k); } \
            if (sg == (GRP)) {                               \
                if ((n) + 1 < 64) { LAS unsigned char* nb = F.lds + (((n) + 1) & 1) * DN_LBUF; \
                    _Pragma("unroll") for (int k = 0; k < 28; ++k) *(LAS u32x4*)(nb + (tg + 128 * k) * 16) = stg[k]; } \
                if ((n) + 3 < 64) { \
                    _Pragma("unroll") for (int k = 0; k < 28; ++k) stg[k] = BLD16(tg * 16, ((n) + 3) * DR_BYTES + 2048 * k); } } \
            if ((n) > 0) dn_epilogue(t2v, Ob + (((n) - 1) & 1) * 16384, zr, nwl, OD, b * SEQ + ((n) - 1) * 64, h); \
            LDS_BARRIER();                                   \
        } while (0)
#pragma unroll 1
        for (int n = 0; n < 64; n += 2) { SC_STAGE(n, 1); SC_STAGE(n + 1, 0); }
#undef SC_STAGE
        { u32x4 zr[4]; const bf16_t* zp_ = ZD + (size_t)(b * SEQ + 63 * 64 + (t2 >> 2)) * 2048 + h * 128 + 32 * (t2 & 3);
#pragma unroll
          for (int k = 0; k < 4; ++k) zr[k] = *(const u32x4*)(zp_ + 8 * k);
          dn_epilogue(t2, Ob + 16384, zr, nwl, OD, b * SEQ + 63 * 64, h); }
        LDS_BARRIER();
    }
#undef BLD16
}

#ifdef MK_ATTN_TAIL
#define MK_ATTN_LAST nfirst
#else
#define MK_ATTN_LAST natt
#endif
#ifndef REP_SCAN
#define REP_SCAN 1
#endif
#ifndef REP_ATTN
#define REP_ATTN 1
#endif
#ifndef REP_P0
#define REP_P0 1
#endif
#ifndef REP_P1
#define REP_P1 1
#endif
#ifndef REP_P2
#define REP_P2 1
#endif
#ifndef REP_P4
#define REP_P4 1
#endif
#ifndef REP_P6
#define REP_P6 1
#endif
#ifndef REP_P8
#define REP_P8 1
#endif
#ifndef REP_P9
#define REP_P9 1
#endif
#ifndef REP_P10
#define REP_P10 1
#endif
#ifndef WGM_IN
#define WGM_IN 8
#endif
#ifndef WGM_UP
#define WGM_UP 4
#endif
#ifndef WGM_SQ
#define WGM_SQ 4
#endif
#ifndef MK_STAGGER_IN
#define MK_STAGGER_IN 0
#endif
#ifndef MK_STAGGER_UP
#define MK_STAGGER_UP 0
#endif
__device__ __forceinline__ void stagger_delay(unsigned ticks) {
    const unsigned long long t0 = __builtin_amdgcn_s_memrealtime();
    while ((unsigned long long)__builtin_amdgcn_s_memrealtime() - t0 < (unsigned long long)ticks) __builtin_amdgcn_s_sleep(8);
}
__global__ void __launch_bounds__(NTHREADS, 2) mk_fwd(Args args) {
    extern __shared__ __attribute__((aligned(16))) unsigned char lds_raw[];
    Frame F;
    F.lds = (LAS unsigned char*)lds_raw;
    F.tid = threadIdx.x; F.lane = F.tid & 63; F.wave = __builtin_amdgcn_readfirstlane(F.tid >> 6);
    typedef const __attribute__((address_space(4))) Args* kargs_t;
    kargs_t ap = (kargs_t)__builtin_amdgcn_kernarg_segment_ptr();
    F.ws = ap->ws; F.x = (const float*)ap->in[0]; F.pos = (const int*)ap->in[1]; F.out = ap->out;
    unsigned* ctl = (unsigned*)(F.ws + WS_CTL);
    volatile LAS unsigned* MISC = (volatile LAS unsigned*)(F.lds + MISC_OFF);
#if MK_ONE_LAUNCH
    if (F.tid < 64) MISC[F.tid] = 0u;
    __syncthreads();
    XcdBarrier bar = xcd_barrier_post(ctl + CW_BAR, MISC);
#define GRID_BAR() xcd_barrier(bar)
#else
#define GRID_BAR() do { } while (0)
#endif
    const int lo = ap->ph_lo, hi = ap->ph_hi;
    const int G = (int)gridDim.x, bx = (int)blockIdx.x;
#define XN ((bf16_t*)(F.ws + WS_XN))
#define QA ((bf16_t*)(F.ws + WS_QA))
#define KA ((bf16_t*)(F.ws + WS_KA))
#define VA ((bf16_t*)(F.ws + WS_VA))
#define QKVD ((bf16_t*)(F.ws + WS_QKVD))
#define ZD ((bf16_t*)(F.ws + WS_ZD))
#define GA ((bf16_t*)(F.ws + WS_GA))
#define GD ((bf16_t*)(F.ws + WS_GD))
#define BAf ((float*)(F.ws + WS_BA))
#define ROPE ((float*)(F.ws + WS_ROPE))
#define Y GA
#define OA XN
#define MIX QKVD
#define UF QKVD
#define ACT ((bf16_t*)(F.ws + WS_DN))
#define FO QA
#define OD QKVD

    for (int l = 0; l < DEPTH; ++l) {
        const int pb = l * NPH;
#define IN(p) (lo <= pb + (p) && pb + (p) < hi)
#define REFRAME() do { int t_ = threadIdx.x; asm volatile("" : "+v"(t_)); F.tid = t_; F.lane = t_ & 63; F.wave = __builtin_amdgcn_readfirstlane(t_ >> 6); \
        ap = (kargs_t)__builtin_amdgcn_kernarg_segment_ptr(); asm volatile("" : "+s"(ap)); F.ws = ap->ws; F.x = (const float*)ap->in[0]; F.pos = (const int*)ap->in[1]; F.out = ap->out; } while (0)
#define SEAM(p) do { if (pb + (p) + 1 < hi) GRID_BAR(); } while (0)
#ifndef NO_P0
        if (IN(0)) { REFRAME();
            ph_convert_weights(F, ap, l);
            if (l == 0) { ph_rope_table(F); ph_norm_first(F, F.x, (const float*)ap->in[2], XN); }
            SEAM(0);
        }
#endif
#ifndef NO_P1
        if (IN(1)) { REFRAME();
#if MK_STAGGER_IN > 0
            if (bx & 1) stagger_delay(MK_STAGGER_IN);
#endif
            for (int rep_ = 0; rep_ < REP_P1; ++rep_) { pg8::Gemm g{XN, (const bf16_t*)(F.ws + WT_IN), T, NIN, D}; pg8::StaticOrder S; S.init(T, NIN, G, bx, WGM_IN);
            pg8::EpiInProj E{QA, KA, VA, QKVD, ZD, GA, GD, BAf, ROPE};
            pg8::gemm_phase<pg8::EpiInProj, pg8::StaticOrder, true, true, (MK_PRESTAGE & 1) != 0>(F.lds, g, S, E);
             }
            SEAM(1);
        }
#endif
#ifndef NO_P2
        if (IN(2)) { REFRAME();
            for (int rep_ = 0; rep_ < REP_P2; ++rep_) { ph_dn_prep(F, QKVD, BAf, (const float*)ap->in[5] + (size_t)l * 4 * 6144, (const float*)ap->in[6] + l * 16, (const float*)ap->in[7] + l * 16, F.ws + WS_DN);
 }
                        SEAM(2);
        }
#endif
#ifndef NO_P3
        if (IN(3)) { REFRAME();
            { const int half = G / 2;
              const int natt = NB * 32 * 4, nrnd = (G - half) > 0 ? (natt - half) / (G - half) : 0, nfirst = nrnd * (G - half);
              if (bx < half) { for (int rs_ = 0; rs_ < REP_SCAN; ++rs_) for (int it = bx; it < NB * 16; it += half) ph_dn_scan(F, it, ZD, OD, (const float*)ap->in[8] + l * 128, F.ws + WS_DN);
#ifdef MK_ATTN_TAIL
                  ph_attn(F, QA, OA, KA, VA, (const float*)ap->in[4] + l * 16, nfirst + bx, half, natt);
#endif
              }
              else { for (int ra_ = 0; ra_ < REP_ATTN; ++ra_) ph_attn(F, QA, OA, KA, VA, (const float*)ap->in[4] + l * 16, bx - half, G - half, MK_ATTN_LAST); } }
            SEAM(3);
        }
#endif
#ifndef NO_P4
        if (IN(4)) { REFRAME();
            for (int rep_ = 0; rep_ < REP_P4; ++rep_) { pg8::Gemm g{OA, (const bf16_t*)(F.ws + WT_BA), T, D, D}; pg8::StaticOrder S; S.init(T, D, G, bx, WGM_SQ);
            pg8::EpiGate<0> E{Y, GA};
            pg8::gemm_phase<pg8::EpiGate<0>, pg8::StaticOrder, true, true, (MK_PRESTAGE & 8) != 0>(F.lds, g, S, E);
             }
#ifndef MK_NO_SEAM4
            SEAM(4);
#endif
        }
#endif
#ifndef NO_P5
        if (IN(5)) { REFRAME();
            pg8::Gemm g{OD, (const bf16_t*)(F.ws + WT_BD), T, D, D}; pg8::StaticOrder S; S.init(T, D, G, bx, WGM_SQ);
            pg8::EpiGate<1> E{Y, GD};
            pg8::gemm_phase<pg8::EpiGate<1>, pg8::StaticOrder, true, true, (MK_PRESTAGE & 8) != 0>(F.lds, g, S, E);
            SEAM(5);
        }
#endif
#ifndef NO_P6
        if (IN(6)) { REFRAME();
            for (int rep_ = 0; rep_ < REP_P6; ++rep_) { pg8::Gemm g{Y, (const bf16_t*)(F.ws + WT_OUT), T, D, D}; pg8::StaticOrder S; S.init(T, D, G, bx, WGM_SQ);
            pg8::EpiPlain E{MIX, D};
            pg8::gemm_phase<pg8::EpiPlain, pg8::StaticOrder, true, true, (MK_PRESTAGE & 4) != 0>(F.lds, g, S, E);
             }
            SEAM(6);
        }
#endif
#ifndef NO_P7
        if (IN(7)) { REFRAME();
            if (l == 0) ph_norm_res<false, true>(F, MIX, (const float*)ap->in[12] + (size_t)l * D, F.x, F.out, (const float*)ap->in[13] + (size_t)l * D, XN);
            else ph_norm_res<true, true>(F, MIX, (const float*)ap->in[12] + (size_t)l * D, F.out, (l == DEPTH - 1) ? (void*)(F.ws + WS_HTAIL) : (void*)F.out, (const float*)ap->in[13] + (size_t)l * D, XN);
            SEAM(7);
        }
#endif
#ifndef NO_P8
        if (IN(8)) { REFRAME();
            for (int rep_ = 0; rep_ < REP_P8; ++rep_) { pg8::Gemm g{XN, (const bf16_t*)(F.ws + WT_UP), T, NUP, D}; pg8::StaticOrder S; S.init(T, NUP, G, bx, WGM_UP);
            pg8::EpiConvGlu E{ACT, (float*)(F.ws + WS_QKVD), (float*)(F.ws + WS_QKVD + 64 * MiB), (const float*)ap->in[15] + (size_t)l * 3 * NUP, (const float*)ap->in[16] + (size_t)l * NUP, F.lds + pg8::STAGE_BYTES};
            pg8::gemm_phase<pg8::EpiConvGlu, pg8::StaticOrder, true, true, (MK_PRESTAGE & 2) != 0>(F.lds, g, S, E);
             }
            SEAM(8);
        }
#endif
#ifndef NO_P9
        if (IN(9)) { REFRAME();
            for (int rep_ = 0; rep_ < REP_P9; ++rep_) { ph_ffn_fixup(F, (const float*)(F.ws + WS_QKVD), (const float*)(F.ws + WS_QKVD + 64 * MiB), (const float*)ap->in[15] + (size_t)l * 3 * NUP, ACT);
             }
            SEAM(9);
        }
#endif
#ifndef NO_P10
        if (IN(10)) { REFRAME();
            for (int rep_ = 0; rep_ < REP_P10; ++rep_) { pg8::Gemm g{ACT, (const bf16_t*)(F.ws + WT_DOWN), T, D, DFF}; pg8::StaticOrder S; S.init(T, D, G, bx, WGM_SQ);
            pg8::EpiPlain E{FO, D};
            pg8::gemm_phase<pg8::EpiPlain, pg8::StaticOrder, true, true, (MK_PRESTAGE & 4) != 0>(F.lds, g, S, E);
             }
#ifdef PROBE_DOWN_B
            { pg8::Gemm g{ACT, (const bf16_t*)(F.ws + WT_DOWN), 2 * T, D, D}; pg8::StaticOrder S; S.init(2 * T, D, G, bx, WGM_SQ);
#ifdef PROBE_DOWN_C
              pg8::EpiNull E{(bf16_t*)(F.ws + WS_QKVD), D};
              pg8::gemm_phase<pg8::EpiNull, pg8::StaticOrder, true, true>(F.lds, g, S, E); }
#else
              pg8::EpiPlain E{(bf16_t*)(F.ws + WS_QKVD), D};
              pg8::gemm_phase<pg8::EpiPlain, pg8::StaticOrder, true, true>(F.lds, g, S, E); }
#endif
#endif
            SEAM(10);
        }
#endif
#ifndef NO_P11
        if (IN(11)) { REFRAME();
            if (l + 1 < DEPTH) ph_norm_res<true, true>(F, FO, (const float*)ap->in[18] + (size_t)l * D, F.out, F.out, (const float*)ap->in[2] + (size_t)(l + 1) * D, XN);
            else ph_norm_res<true, false>(F, FO, (const float*)ap->in[18] + (size_t)l * D, F.ws + WS_HTAIL, F.out, nullptr, XN);
            SEAM(11);
        }
#endif
#undef IN
#undef REFRAME
#undef SEAM
    }
}
#undef XN
#undef QA
#undef KA
#undef VA
#undef QKVD
#undef ZD
#undef GA
#undef GD
#undef BAf
#undef ROPE
#undef Y
#undef OA
#undef MIX
#undef UF
#undef ACT
#undef FO
#undef OD

extern "C" void kernel_launch(void* const* d_in, const int* in_sizes, int n_in, void* d_out, int out_size, void* d_ws, size_t ws_size, hipStream_t stream) {
    static int grid = 0;
    if (grid == 0) {
        if (n_in != 19 || out_size != T * D || ws_size < WS_END) { fprintf(stderr, "kernel_launch: unexpected problem shape (n_in %d out %d ws %zu)\n", n_in, out_size, ws_size); grid = -1; return; }
        int dev = 0, cus = 0, per_cu = 0;
        if (hipGetDevice(&dev) != hipSuccess || hipDeviceGetAttribute(&cus, hipDeviceAttributeMultiprocessorCount, dev) != hipSuccess) { grid = -1; return; }
        if (hipFuncSetAttribute((const void*)mk_fwd, hipFuncAttributeMaxDynamicSharedMemorySize, LDS_BYTES) != hipSuccess) { fprintf(stderr, "kernel_launch: hipFuncSetAttribute failed\n"); grid = -1; return; }
        if (hipOccupancyMaxActiveBlocksPerMultiprocessor(&per_cu, (const void*)mk_fwd, NTHREADS, LDS_BYTES) != hipSuccess || per_cu < 1) fprintf(stderr, "kernel_launch: occupancy query reports %d\n", per_cu);
        (void)hipGetLastError();
        grid = cus;
    }
    if (grid < 0) return;
    if (hipMemsetAsync((char*)d_ws + WS_CTL, 0, CTL_ZERO_BYTES, stream) != hipSuccess) return;
    Args a{};
    for (int i = 0; i < 19; ++i) a.in[i] = d_in[i];
    a.out = (float*)d_out; a.ws = (unsigned char*)d_ws;
#if MK_ONE_LAUNCH
    a.ph_lo = 0; a.ph_hi = NPHASES;
    hipLaunchKernelGGL(mk_fwd, dim3(grid), dim3(NTHREADS), LDS_BYTES, stream, a);
#else
    for (int p = 0; p < NPHASES; ++p) { a.ph_lo = p; a.ph_hi = p + 1; hipLaunchKernelGGL(mk_fwd, dim3(grid), dim3(NTHREADS), LDS_BYTES, stream, a);
#ifdef MK_PROBE_DUP_PHASE
        if (p % NPH == MK_PROBE_DUP_PHASE) hipLaunchKernelGGL(mk_fwd, dim3(grid), dim3(NTHREADS), LDS_BYTES, stream, a);
#endif
    }
#endif
}
```

```cpp
#include <hip/hip_runtime.h>
#include <cstdio>
#include <cstdint>

#ifndef MK_ONE_LAUNCH
#define MK_ONE_LAUNCH 1
#endif
#ifndef MK_CONVW_LDS
#define MK_CONVW_LDS 1
#endif
#ifndef MK_SEAM4
#define MK_SEAM4 0
#endif
#ifndef MK_PRESTAGE
#define MK_PRESTAGE 1
#endif

typedef __bf16 bf16x2n_t __attribute__((ext_vector_type(2)));
typedef float f32x2n_t __attribute__((ext_vector_type(2)));
__device__ __forceinline__ unsigned pk2(float lo, float hi) { f32x2n_t v = {lo, hi}; return __builtin_bit_cast(unsigned, __builtin_convertvector(v, bf16x2n_t)); }
__device__ __forceinline__ float bf_lo(unsigned w) { return __uint_as_float(w << 16); }
__device__ __forceinline__ float bf_hi(unsigned w) { return __uint_as_float(w & 0xffff0000u); }
__device__ __forceinline__ float bf1(unsigned short h) { return __uint_as_float(((unsigned)h) << 16); }
__device__ __forceinline__ float sigmoidf_(float x) { return __builtin_amdgcn_rcpf(1.0f + __expf(-x)); }
__device__ __forceinline__ float siluf_(float x) { return x * __builtin_amdgcn_rcpf(1.0f + __expf(-x)); }

namespace pg8 {
#define PG8_LAS __attribute__((address_space(3)))
typedef unsigned short bf16_t;
typedef short bf16x8 __attribute__((ext_vector_type(8)));
typedef float f32x4 __attribute__((ext_vector_type(4)));
typedef unsigned u32x4 __attribute__((ext_vector_type(4)));
constexpr int BM = 256, BK = 64, HALF = 128, HTB = HALF * BK * 2  , STAGE_BYTES = 8 * HTB, NXCD = 8, WGM = 8;

__host__ __device__ __forceinline__ int lds_byte(int r, int c) { const int st = (r >> 4) * 2 + (c >> 5), rr = r & 15, cc = c & 31, ob = rr * 64 + cc * 2; return st * 1024 + (ob ^ (((ob >> 9) & 1) << 5)); }
__host__ __device__ __forceinline__ void stage_rc(int b, int& R, int& C) { const int st = b / 1024, sb = b % 1024, swz = sb ^ (((sb >> 9) & 1) << 5); R = (st >> 1) * 16 + swz / 64; C = (st & 1) * 32 + (swz % 64) / 2; }
__host__ __device__ __forceinline__ int perm32(int rho) { const int n = rho >> 4, i = rho & 15; return 8 * (i >> 2) + 4 * n + (i & 3); }

struct Unit { int pm, pn, idx; };
struct Gemm { const bf16_t* A; const bf16_t* Bt; int M, N, K; };

struct StaticOrder {
    int nM, nN, nwg, G, c, wgm;
    __host__ __device__ void init(int M, int N, int G_, int c_, int wgm_ = 4) { nM = M / BM; nN = N / BM; nwg = nM * nN; G = G_; c = c_; wgm = wgm_; }
    __host__ __device__ bool next(int i, Unit& u) const {
        const long L = (long)i * G + c; if (L >= nwg) return false;
        int wgid = (int)L; { const int q = nwg / NXCD, r = nwg % NXCD, xcd = wgid % NXCD, off = wgid / NXCD; wgid = (xcd < r ? xcd * (q + 1) : r * (q + 1) + (xcd - r) * q) + off; }
        const int nig = wgm * nN, gid = wgid / nig, fm = gid * wgm, gsz = (nM - fm) < wgm ? (nM - fm) : wgm;
        u.pm = fm + ((wgid % nig) % gsz); u.pn = (wgid % nig) / gsz; u.idx = i; return true;
    }
    __device__ __forceinline__ void a_ready(const Unit&) const {}
    __device__ __forceinline__ void done(const Unit&) const {}
};

__device__ __forceinline__ u32x4 pack8v(const f32x4 v0, const f32x4 v1) { u32x4 w; w.x = pk2(v0[0], v0[1]); w.y = pk2(v0[2], v0[3]); w.z = pk2(v1[0], v1[1]); w.w = pk2(v1[2], v1[3]); return w; }
__device__ __forceinline__ void unpack8v(const u32x4 w, f32x4& v0, f32x4& v1) { v0[0] = bf_lo(w.x); v0[1] = bf_hi(w.x); v0[2] = bf_lo(w.y); v0[3] = bf_hi(w.y); v1[0] = bf_lo(w.z); v1[1] = bf_hi(w.z); v1[2] = bf_lo(w.w); v1[3] = bf_hi(w.w); }

struct EpiPlain {
    static constexpr bool PERM = true, AFTER_DRAIN = false, STAGE_W = false;
    __device__ __forceinline__ int min_vm(const Unit&) const { return 16; }
    bf16_t* O; int ldc;
    __device__ __forceinline__ void operator()(const f32x4 (&acc)[2][2][4][2], const Unit& u, int wr, int wc, int fr, int fq) const {
        const int row0 = u.pm * BM + wr * 64 + fr, col0 = u.pn * BM + wc * 32 + 8 * fq;
#pragma unroll
        for (int ai = 0; ai < 2; ++ai)
#pragma unroll
            for (int m = 0; m < 4; ++m) { bf16_t* rowp = O + (size_t)(row0 + ai * HALF + m * 16) * ldc + col0;
#pragma unroll
                for (int bj = 0; bj < 2; ++bj) *(u32x4*)(rowp + bj * HALF) = pack8v(acc[ai][bj][m][0], acc[ai][bj][m][1]); }
    }
};

#ifdef PROBE_DOWN_C
struct EpiNull {
    static constexpr bool PERM = true, AFTER_DRAIN = false, STAGE_W = false;
    __device__ __forceinline__ int min_vm(const Unit&) const { return 0; }
    bf16_t* O; int ldc;
    __device__ __forceinline__ void operator()(const f32x4 (&acc)[2][2][4][2], const Unit& u, int wr, int wc, int fr, int fq) const {
        float s = 0.f;
#pragma unroll
        for (int ai = 0; ai < 2; ++ai)
#pragma unroll
            for (int bj = 0; bj < 2; ++bj)
#pragma unroll
            for (int m = 0; m < 4; ++m)
#pragma unroll
            for (int n = 0; n < 2; ++n) s += acc[ai][bj][m][n][0] + acc[ai][bj][m][n][1] + acc[ai][bj][m][n][2] + acc[ai][bj][m][n][3];
        if (s == 123456.789f) O[(size_t)(u.pm * BM + wr * 64 + fr) * ldc + u.pn * BM + wc * 32 + 8 * fq] = (bf16_t)1;
    }
};
#endif
struct EpiInProj {
    static constexpr bool PERM = true, AFTER_DRAIN = false, STAGE_W = false;
    __device__ __forceinline__ int min_vm(const Unit& u) const { return u.pn == 60 ? 0 : 16; }
    bf16_t *QA, *KA, *VA, *QKVD, *ZD, *GA, *GD; float* BAf; const float* rope;
    __device__ __forceinline__ void operator()(const f32x4 (&acc)[2][2][4][2], const Unit& u, int wr, int wc, int fr, int fq) const {
        const int pn = u.pn; const int row0 = u.pm * BM + wr * 64 + fr;
        if (pn == 60) {
            if (wc == 0) {
#pragma unroll
                for (int ai = 0; ai < 2; ++ai)
#pragma unroll
                    for (int m = 0; m < 4; ++m) { float* p = BAf + (size_t)(row0 + ai * HALF + m * 16) * 32 + 8 * fq; *(f32x4*)p = acc[ai][0][m][0]; *(f32x4*)(p + 4) = acc[ai][0][m][1]; }
            }
            return;
        }
        bf16_t* base; int ldc, colt; bool rope_on = false;
        if (pn < 8) { base = QA; ldc = 2048; colt = pn * 256; rope_on = true; }
        else if (pn < 10) { base = KA; ldc = 512; colt = (pn - 8) * 256; rope_on = true; }
        else if (pn < 12) { base = VA; ldc = 512; colt = (pn - 10) * 256; }
        else if (pn < 36) { base = QKVD; ldc = 6144; colt = (pn - 12) * 256; }
        else if (pn < 44) { base = ZD; ldc = 2048; colt = (pn - 36) * 256; }
        else if (pn < 52) { base = GA; ldc = 2048; colt = (pn - 44) * 256; }
        else { base = GD; ldc = 2048; colt = (pn - 52) * 256; }
        const int col0 = colt + wc * 32 + 8 * fq;
        const bool do_rope = rope_on && (wc == 0);
        const float sg = (fq < 2) ? -1.f : 1.f;
#pragma unroll
        for (int ai = 0; ai < 2; ++ai)
#pragma unroll
            for (int m = 0; m < 4; ++m) { const int row = row0 + ai * HALF + m * 16; bf16_t* rowp = base + (size_t)row * ldc + col0;
                f32x4 c0 = {1.f, 1.f, 1.f, 1.f}, c1 = c0, s0 = {0.f, 0.f, 0.f, 0.f}, s1 = s0;
                if (do_rope) { const float* rp = rope + (size_t)row * 32 + 8 * (fq & 1); c0 = *(const f32x4*)rp; c1 = *(const f32x4*)(rp + 4); s0 = *(const f32x4*)(rp + 16); s1 = *(const f32x4*)(rp + 20); }
#pragma unroll
                for (int bj = 0; bj < 2; ++bj) { f32x4 v0 = acc[ai][bj][m][0], v1 = acc[ai][bj][m][1];
                    if (do_rope) { f32x4 p0, p1;
#pragma unroll
                        for (int e = 0; e < 4; ++e) { p0[e] = __shfl_xor(v0[e], 32); p1[e] = __shfl_xor(v1[e], 32); }
                        v0 = v0 * c0 + sg * (p0 * s0); v1 = v1 * c1 + sg * (p1 * s1); }
                    *(u32x4*)(rowp + bj * HALF) = pack8v(v0, v1); } }
    }
};

template <int MODE> struct EpiGate {
    static constexpr bool PERM = true, AFTER_DRAIN = false, STAGE_W = false;
    __device__ __forceinline__ int min_vm(const Unit&) const { return 16; }
    bf16_t* Y; const bf16_t* G;
    __device__ __forceinline__ void operator()(const f32x4 (&acc)[2][2][4][2], const Unit& u, int wr, int wc, int fr, int fq) const {
        const int row0 = u.pm * BM + wr * 64 + fr, col0 = u.pn * BM + wc * 32 + 8 * fq;
        const size_t off0 = (size_t)row0 * 2048 + col0;
        u32x4 gn = *(const u32x4*)(G + off0), yn = {0u, 0u, 0u, 0u};
        if (MODE == 1) yn = *(const u32x4*)(Y + off0);
#pragma unroll
        for (int k = 0; k < 16; ++k) { const int ai = k >> 3, m = (k >> 1) & 3, bj = k & 1;
            const size_t off = (size_t)(row0 + ai * HALF + m * 16) * 2048 + col0 + bj * HALF;
            const u32x4 gc = gn, yc = yn;
            if (k + 1 < 16) { const int ai2 = (k + 1) >> 3, m2 = ((k + 1) >> 1) & 3, bj2 = (k + 1) & 1; const size_t off2 = (size_t)(row0 + ai2 * HALF + m2 * 16) * 2048 + col0 + bj2 * HALF;
                gn = *(const u32x4*)(G + off2); if (MODE == 1) yn = *(const u32x4*)(Y + off2); }
            f32x4 g0, g1; unpack8v(gc, g0, g1);
            f32x4 v0 = acc[ai][bj][m][0], v1 = acc[ai][bj][m][1];
#pragma unroll
            for (int e2 = 0; e2 < 4; ++e2) { v0[e2] *= sigmoidf_(g0[e2]); v1[e2] *= sigmoidf_(g1[e2]); }
            if (MODE == 1) { f32x4 y0, y1; unpack8v(yc, y0, y1); v0 += y0; v1 += y1; }
            *(u32x4*)(Y + off) = pack8v(v0, v1); }
    }
};

__device__ __forceinline__ float dpp_ror1(float v) { return __builtin_bit_cast(float, __builtin_amdgcn_update_dpp(0, __builtin_bit_cast(int, v), 0x121, 0xf, 0xf, false)); }
__device__ __forceinline__ float dpp_ror2(float v) { return __builtin_bit_cast(float, __builtin_amdgcn_update_dpp(0, __builtin_bit_cast(int, v), 0x122, 0xf, 0xf, false)); }
__device__ __forceinline__ float dpp_shr1(float v) { return __builtin_bit_cast(float, __builtin_amdgcn_update_dpp(0, __builtin_bit_cast(int, v), 0x111, 0xf, 0xf, true)); }
__device__ __forceinline__ float dpp_shr2(float v) { return __builtin_bit_cast(float, __builtin_amdgcn_update_dpp(0, __builtin_bit_cast(int, v), 0x112, 0xf, 0xf, true)); }
__device__ __forceinline__ float dpp_shl15(float v) { return __builtin_bit_cast(float, __builtin_amdgcn_update_dpp(0, __builtin_bit_cast(int, v), 0x10F, 0xf, 0xf, true)); }
__device__ __forceinline__ float dpp_shl14(float v) { return __builtin_bit_cast(float, __builtin_amdgcn_update_dpp(0, __builtin_bit_cast(int, v), 0x10E, 0xf, 0xf, true)); }
typedef unsigned u32x2e __attribute__((ext_vector_type(2)));
struct EpiConvGlu {
    static constexpr bool PERM = true, AFTER_DRAIN = false, STAGE_W = (MK_CONVW_LDS != 0);
    __device__ __forceinline__ int min_vm(const Unit&) const { return 16; }
    bf16_t* ACT; float* PART; float* TAIL; const float* cw; const float* cb;
    PG8_LAS unsigned char* wl;
    __device__ __forceinline__ void stage_w(const Unit& u, int wid, int lane) const {
        if (wid < 4) { const float* src = ((wid < 3) ? cw + wid * 11264 : cb) + ((lane < 32) ? 0 : 5632) + u.pn * 128 + 4 * (lane & 31);
            __builtin_amdgcn_global_load_lds((const unsigned*)src, (PG8_LAS unsigned*)(wl + (u.idx & 1) * 4096 + wid * 1024), 16, 0, 0); }
    }
    __device__ __forceinline__ void operator()(const f32x4 (&acc)[2][2][4][2], const Unit& u, int wr, int wc, int fr, int fq) const {
#pragma unroll
        for (int n = 0; n < 2; ++n) {
            const int ch = u.pn * 128 + wc * 32 + 8 * fq + 4 * n;
            f32x4 wg[3], wv[3], bg, bv;
            if constexpr (STAGE_W) { const PG8_LAS float* wb = (const PG8_LAS float*)(wl + (u.idx & 1) * 4096) + wc * 32 + 8 * fq + 4 * n;
#pragma unroll
                for (int j = 0; j < 3; ++j) { wg[j] = *(const PG8_LAS f32x4*)(wb + j * 256); wv[j] = *(const PG8_LAS f32x4*)(wb + j * 256 + 128); }
                bg = *(const PG8_LAS f32x4*)(wb + 768); bv = *(const PG8_LAS f32x4*)(wb + 768 + 128);
            } else {
#pragma unroll
                for (int j = 0; j < 3; ++j) { wg[j] = *(const f32x4*)(cw + j * 11264 + ch); wv[j] = *(const f32x4*)(cw + j * 11264 + 5632 + ch); }
                bg = *(const f32x4*)(cb + ch); bv = *(const f32x4*)(cb + 5632 + ch); }
#pragma unroll
            for (int ai = 0; ai < 2; ++ai) {
                const int brow0 = u.pm * BM + ai * HALF + wr * 64, gb = brow0 >> 6;
#pragma unroll
                for (int m = 0; m < 4; ++m) {
                    f32x4 g, v;
#pragma unroll
                    for (int e = 0; e < 4; e += 2) {
                        const float cg0 = acc[ai][0][m][n][e], cv0 = acc[ai][1][m][n][e], cg1 = acc[ai][0][m][n][e + 1], cv1 = acc[ai][1][m][n][e + 1];
                        float g0 = fmaf(wg[2][e], cg0, bg[e]), v0 = fmaf(wv[2][e], cv0, bv[e]), g1 = fmaf(wg[2][e + 1], cg1, bg[e + 1]), v1 = fmaf(wv[2][e + 1], cv1, bv[e + 1]);
                        asm volatile("s_nop 1\n\t"
                            "v_fmac_f32_dpp %0, %4, %8 row_shr:1 row_mask:0xf bank_mask:0xf\n\t"
                            "v_fmac_f32_dpp %1, %5, %9 row_shr:1 row_mask:0xf bank_mask:0xf\n\t"
                            "v_fmac_f32_dpp %2, %6, %10 row_shr:1 row_mask:0xf bank_mask:0xf\n\t"
                            "v_fmac_f32_dpp %3, %7, %11 row_shr:1 row_mask:0xf bank_mask:0xf\n\t"
                            "v_fmac_f32_dpp %0, %4, %12 row_shr:2 row_mask:0xf bank_mask:0xf\n\t"
                            "v_fmac_f32_dpp %1, %5, %13 row_shr:2 row_mask:0xf bank_mask:0xf\n\t"
                            "v_fmac_f32_dpp %2, %6, %14 row_shr:2 row_mask:0xf bank_mask:0xf\n\t"
                            "v_fmac_f32_dpp %3, %7, %15 row_shr:2 row_mask:0xf bank_mask:0xf"
                            : "+v"(g0), "+v"(v0), "+v"(g1), "+v"(v1)
                            : "v"(cg0), "v"(cv0), "v"(cg1), "v"(cv1), "v"(wg[1][e]), "v"(wv[1][e]), "v"(wg[1][e + 1]), "v"(wv[1][e + 1]), "v"(wg[0][e]), "v"(wv[0][e]), "v"(wg[0][e + 1]), "v"(wv[0][e + 1]));
                        if (m > 0) { const float pg0 = acc[ai][0][m - 1][n][e], pv0 = acc[ai][1][m - 1][n][e], pg1 = acc[ai][0][m - 1][n][e + 1], pv1 = acc[ai][1][m - 1][n][e + 1];
                            asm volatile("s_nop 1\n\t"
                                "v_fmac_f32_dpp %0, %4, %8 row_shl:15 row_mask:0xf bank_mask:0xf\n\t"
                                "v_fmac_f32_dpp %1, %5, %9 row_shl:15 row_mask:0xf bank_mask:0xf\n\t"
                                "v_fmac_f32_dpp %2, %6, %10 row_shl:15 row_mask:0xf bank_mask:0xf\n\t"
                                "v_fmac_f32_dpp %3, %7, %11 row_shl:15 row_mask:0xf bank_mask:0xf\n\t"
                                "v_fmac_f32_dpp %0, %4, %12 row_shl:14 row_mask:0xf bank_mask:0xf\n\t"
                                "v_fmac_f32_dpp %1, %5, %13 row_shl:14 row_mask:0xf bank_mask:0xf\n\t"
                                "v_fmac_f32_dpp %2, %6, %14 row_shl:14 row_mask:0xf bank_mask:0xf\n\t"
                                "v_fmac_f32_dpp %3, %7, %15 row_shl:14 row_mask:0xf bank_mask:0xf"
                                : "+v"(g0), "+v"(v0), "+v"(g1), "+v"(v1)
                                : "v"(pg0), "v"(pv0), "v"(pg1), "v"(pv1), "v"(wg[1][e]), "v"(wv[1][e]), "v"(wg[1][e + 1]), "v"(wv[1][e + 1]), "v"(wg[0][e]), "v"(wv[0][e]), "v"(wg[0][e + 1]), "v"(wv[0][e + 1])); }
                        g[e] = g0; v[e] = v0; g[e + 1] = g1; v[e + 1] = v1;
                    }
                    const int row = brow0 + 16 * m + fr;
                    if (m == 0 && fr < 2) {
                        float* pp = PART + (size_t)(gb * 2 + fr) * 11264 + ch;
                        *(f32x4*)pp = g; *(f32x4*)(pp + 5632) = v;
                    } else {
                        u32x2e w; w.x = pk2(siluf_(g[0]) * v[0], siluf_(g[1]) * v[1]); w.y = pk2(siluf_(g[2]) * v[2], siluf_(g[3]) * v[3]);
                        *(u32x2e*)(ACT + (size_t)row * 5632 + ch) = w;
                    }
                    if (m == 3 && fr >= 14) {
                        float* tp = TAIL + (size_t)(gb * 2 + (fr - 14)) * 11264 + ch;
                        *(f32x4*)tp = acc[ai][0][3][n]; *(f32x4*)(tp + 5632) = acc[ai][1][3][n];
                    }
                }
            }
        }
    }
};

template <class Epi, class Sched, bool ALIGN_EPI = false, bool SP2 = false, bool PRE = false>
__device__ __forceinline__ void gemm_phase(PG8_LAS unsigned char* lds, const Gemm g, const Sched& S, const Epi& E) {
    int tid_ = threadIdx.x; asm volatile("" : "+v"(tid_));
    const int tid = tid_, wid = __builtin_amdgcn_readfirstlane(tid >> 6), lane = tid & 63, wr = wid >> 2, wc = wid & 3, fr = lane & 15, fq = lane >> 4;
    const int K = g.K, nt = K / BK;
    unsigned voffA[2], voffB[2];
#pragma unroll
    for (int i = 0; i < 2; ++i) { int R, C; stage_rc(tid * 16 + i * 8192, R, C); const int Rb = Epi::PERM ? ((R & ~31) + perm32(R & 31)) : R;
        voffA[i] = (unsigned)(R * K + C) * 2u; voffB[i] = (unsigned)(Rb * K + C) * 2u; }
    const size_t kstep = (size_t)(BK * 2);
    const size_t hstep = (size_t)HALF * K * 2;
    const size_t tstep = 2 * hstep;
    const unsigned ldsw = (unsigned)wid * 1024u;
    const int aoff = lds_byte(wr * 64 + fr, fq * 8), boff = lds_byte(wc * 32 + fr, fq * 8);
#define PG8_SA(b, h) (((b) * 2 + (h)) * HTB)
#define PG8_SB(b, h) ((4 + (b) * 2 + (h)) * HTB)
#define PG8_STAGE(bufoff, gbase, voff) do { _Pragma("unroll") for (int _i = 0; _i < 2; ++_i) \
        __builtin_amdgcn_global_load_lds((const unsigned*)((const char*)(gbase) + (voff)[_i]), (PG8_LAS unsigned*)(lds + (bufoff) + ldsw + _i * 8192), 16, 0, 0); } while (0)
#define PG8_LDA(dst, b, h) do { _Pragma("unroll") for (int m = 0; m < 4; ++m) _Pragma("unroll") for (int k = 0; k < 2; ++k) dst[m][k] = *(const PG8_LAS bf16x8*)(lds + PG8_SA(b, h) + aoff + m * 2048 + k * 1024); } while (0)
#define PG8_LDB(dst, b, h) do { _Pragma("unroll") for (int n = 0; n < 2; ++n) _Pragma("unroll") for (int k = 0; k < 2; ++k) dst[n][k] = *(const PG8_LAS bf16x8*)(lds + PG8_SB(b, h) + boff + n * 2048 + k * 1024); } while (0)
#define PG8_MMA(ai, bj, At, Bt) do { __builtin_amdgcn_s_setprio(1); _Pragma("unroll") for (int m = 0; m < 4; ++m) _Pragma("unroll") for (int n = 0; n < 2; ++n) _Pragma("unroll") for (int k = 0; k < 2; ++k) \
        acc[ai][bj][m][n] = __builtin_amdgcn_mfma_f32_16x16x32_bf16(Bt[n][k], At[m][k], acc[ai][bj][m][n], 0, 0, 0); __builtin_amdgcn_s_setprio(0); } while (0)
#define PG8_WAIT_V(n) asm volatile("s_waitcnt vmcnt(" #n ")" ::: "memory")
#define PG8_WAIT_L(n) asm volatile("s_waitcnt lgkmcnt(" #n ")" ::: "memory")
#define PG8_BAR __builtin_amdgcn_s_barrier()
#define PG8_SCHED __builtin_amdgcn_sched_barrier(0)
    Unit cur, nxt; int ui = 0;
    constexpr bool PRESTAGE = ALIGN_EPI && SP2 && PRE; bool relax = false;
    if (!S.next(0, cur)) return;
    if constexpr (Epi::STAGE_W) E.stage_w(cur, wid, lane);
    f32x4 acc[2][2][4][2];
#pragma unroll
    for (int a = 0; a < 2; ++a)
#pragma unroll
        for (int b = 0; b < 2; ++b)
#pragma unroll
            for (int m = 0; m < 4; ++m)
#pragma unroll
                for (int n = 0; n < 2; ++n) acc[a][b][m][n] = (f32x4){0.f, 0.f, 0.f, 0.f};
    bf16x8 At[4][2], B0[2][2], B1[2][2];
    const char* cA = (const char*)g.A + (size_t)cur.pm * tstep; const char* cB = (const char*)g.Bt + (size_t)cur.pn * tstep;
    S.a_ready(cur);
    if constexpr (SP2) {
        PG8_STAGE(PG8_SB(0, 0), cB, voffB); PG8_STAGE(PG8_SB(0, 1), cB + hstep, voffB); PG8_STAGE(PG8_SA(0, 0), cA, voffA); PG8_STAGE(PG8_SA(0, 1), cA + hstep, voffA);
        if (wr == 1) PG8_BAR;
        PG8_WAIT_V(2); PG8_BAR;
        PG8_STAGE(PG8_SB(1, 0), cB + kstep, voffB); PG8_STAGE(PG8_SA(1, 0), cA + kstep, voffA); PG8_STAGE(PG8_SB(1, 1), cB + hstep + kstep, voffB);
        PG8_WAIT_V(6); PG8_BAR;
        if constexpr (PRESTAGE) PG8_STAGE(PG8_SA(1, 1), cA + kstep + hstep, voffA);
    } else {
        PG8_STAGE(PG8_SB(0, 0), cB, voffB); PG8_STAGE(PG8_SA(0, 0), cA, voffA); PG8_STAGE(PG8_SB(0, 1), cB + hstep, voffB); PG8_STAGE(PG8_SA(0, 1), cA + hstep, voffA);
        if (wr == 1) PG8_BAR;
        PG8_WAIT_V(4); PG8_BAR;
        PG8_STAGE(PG8_SB(1, 0), cB + kstep, voffB); PG8_STAGE(PG8_SA(1, 0), cA + kstep, voffA); PG8_STAGE(PG8_SB(1, 1), cB + hstep + kstep, voffB);
        PG8_WAIT_V(6); PG8_BAR;
    }
    for (;;) {
        const bool has_next = S.next(ui + 1, nxt);
        const char* nA = has_next ? (const char*)g.A + (size_t)nxt.pm * tstep : cA; const char* nB = has_next ? (const char*)g.Bt + (size_t)nxt.pn * tstep : cB;
        for (int t = 0; t < nt; t += 2) {
            const bool last = (t == nt - 2);
            const char* a1 = cA + (size_t)(t + 1) * kstep;
            const char* a2 = last ? nA : cA + (size_t)(t + 2) * kstep; const char* b2 = last ? nB : cB + (size_t)(t + 2) * kstep;
            const char* a3 = a2 + kstep; const char* b3 = b2 + kstep;
            if (last && has_next) S.a_ready(nxt);
            if constexpr (SP2) {
            int tz_ = t; if constexpr (PRESTAGE) asm volatile("" : "+s"(tz_));
            const bool rx = PRESTAGE && tz_ == 0 && ui > 0 && relax;
#define PG8_WAIT_R() do { if constexpr (PRESTAGE) { PG8_WAIT_V(24); if (!rx) PG8_WAIT_V(8); } else PG8_WAIT_V(8); } while (0)
            PG8_LDB(B0, 0, 0); PG8_LDB(B1, 0, 1); PG8_SCHED; PG8_LDA(At, 0, 0); if constexpr (!PRESTAGE) PG8_STAGE(PG8_SA(1, 1), a1 + hstep, voffA);
            PG8_WAIT_R(); PG8_WAIT_L(0); PG8_BAR; PG8_MMA(0, 0, At, B0); PG8_MMA(0, 1, At, B1); PG8_BAR; PG8_SCHED;
            PG8_LDA(At, 0, 1); PG8_STAGE(PG8_SB(0, 0), b2, voffB); PG8_STAGE(PG8_SB(0, 1), b2 + hstep, voffB); PG8_STAGE(PG8_SA(0, 0), a2, voffA);
            PG8_WAIT_R(); PG8_WAIT_L(0); PG8_BAR; PG8_MMA(1, 0, At, B0); PG8_MMA(1, 1, At, B1); PG8_BAR; PG8_SCHED;
            PG8_LDB(B0, 1, 0); PG8_LDB(B1, 1, 1); PG8_SCHED; PG8_LDA(At, 1, 0); PG8_STAGE(PG8_SA(0, 1), a2 + hstep, voffA);
            PG8_WAIT_R(); PG8_WAIT_L(0); PG8_BAR; PG8_MMA(0, 0, At, B0); PG8_MMA(0, 1, At, B1); PG8_BAR; PG8_SCHED;
            PG8_LDA(At, 1, 1); PG8_STAGE(PG8_SB(1, 0), b3, voffB); PG8_STAGE(PG8_SB(1, 1), b3 + hstep, voffB); PG8_STAGE(PG8_SA(1, 0), a3, voffA);
            PG8_WAIT_V(8); PG8_WAIT_L(0); PG8_BAR; PG8_MMA(1, 0, At, B0); PG8_MMA(1, 1, At, B1); PG8_BAR; PG8_SCHED;
            if constexpr (PRESTAGE) PG8_STAGE(PG8_SA(1, 1), a3 + hstep, voffA);
#undef PG8_WAIT_R
            } else {
            PG8_LDB(B0, 0, 0); PG8_SCHED; PG8_LDA(At, 0, 0); PG8_STAGE(PG8_SA(1, 1), a1 + hstep, voffA);
            PG8_WAIT_L(8); PG8_BAR; PG8_WAIT_L(0); PG8_MMA(0, 0, At, B0); PG8_BAR; PG8_SCHED;
            PG8_LDB(B1, 0, 1); PG8_STAGE(PG8_SB(0, 0), b2, voffB);
            PG8_BAR; PG8_WAIT_L(0); PG8_MMA(0, 1, At, B1); PG8_BAR;
            PG8_LDA(At, 0, 1); PG8_STAGE(PG8_SA(0, 0), a2, voffA);
            PG8_BAR; PG8_WAIT_L(0); PG8_MMA(1, 0, At, B0); PG8_BAR; PG8_SCHED;
            PG8_STAGE(PG8_SB(0, 1), b2 + hstep, voffB);
            PG8_WAIT_V(6); PG8_BAR; PG8_MMA(1, 1, At, B1); PG8_BAR;
            PG8_LDB(B0, 1, 0); PG8_SCHED; PG8_LDA(At, 1, 0); PG8_STAGE(PG8_SA(0, 1), a2 + hstep, voffA);
            PG8_WAIT_L(8); PG8_BAR; PG8_WAIT_L(0); PG8_MMA(0, 0, At, B0); PG8_BAR; PG8_SCHED;
            PG8_LDB(B1, 1, 1); PG8_STAGE(PG8_SB(1, 0), b3, voffB);
            PG8_BAR; PG8_WAIT_L(0); PG8_MMA(0, 1, At, B1); PG8_BAR;
            PG8_LDA(At, 1, 1); PG8_STAGE(PG8_SA(1, 0), a3, voffA);
            PG8_BAR; PG8_WAIT_L(0); PG8_MMA(1, 0, At, B0); PG8_BAR; PG8_SCHED;
            PG8_STAGE(PG8_SB(1, 1), b3 + hstep, voffB);
            PG8_WAIT_V(6); PG8_BAR; PG8_MMA(1, 1, At, B1); PG8_BAR;
            }
        }
        if constexpr (ALIGN_EPI) { if (wr == 0) PG8_BAR; }
        if constexpr (PRESTAGE) relax = E.min_vm(cur) >= 16;
        if constexpr (Epi::STAGE_W) { if (has_next) E.stage_w(nxt, wid, lane); }
        if constexpr (!Epi::AFTER_DRAIN) { E(acc, cur, wr, wc, fr, fq); S.done(cur); }
        if (!has_next) break;
#pragma unroll
        for (int a = 0; a < 2; ++a)
#pragma unroll
            for (int b = 0; b < 2; ++b)
#pragma unroll
                for (int m = 0; m < 4; ++m)
#pragma unroll
                    for (int n = 0; n < 2; ++n) acc[a][b][m][n] = (f32x4){0.f, 0.f, 0.f, 0.f};
        cur = nxt; cA = nA; cB = nB; ++ui;
        if constexpr (ALIGN_EPI) { if (wr == 1) PG8_BAR; }
    }
    PG8_WAIT_V(0);
    if constexpr (!ALIGN_EPI) { if (wr == 0) PG8_BAR; }
    PG8_BAR;
    if constexpr (Epi::AFTER_DRAIN) { E.fused(acc, cur, wr, wc, fr, fq, lds, wid, lane); S.done(cur); }
#undef PG8_SA
#undef PG8_SB
#undef PG8_STAGE
#undef PG8_LDA
#undef PG8_LDB
#undef PG8_MMA
#undef PG8_WAIT_V
#undef PG8_WAIT_L
#undef PG8_BAR
#undef PG8_SCHED
}
}

#define LAS __attribute__((address_space(3)))
typedef unsigned short bf16_t;
typedef float f32x4 __attribute__((ext_vector_type(4)));
typedef unsigned u32x4 __attribute__((ext_vector_type(4)));
typedef unsigned u32x2 __attribute__((ext_vector_type(2)));
constexpr int NB = 8, SEQ = 4096, T = NB * SEQ, D = 2048, DEPTH = 4;
constexpr int NIN_ORIG = 15392, NIN = 15616, DFF = 5632, NUP = 2 * DFF;
constexpr int NWAVES = 8, NTHREADS = 512;
constexpr float EPS = 1e-6f;
constexpr int NPH = 12;
constexpr int NPHASES = DEPTH * NPH;

constexpr size_t MiB = 1ull << 20;
constexpr size_t WS_CTL = 0, CTL_ZERO_BYTES = 1 * MiB;
constexpr size_t WS_ROPE = 1 * MiB;
constexpr size_t WS_BA = 5 * MiB;
constexpr size_t WT_IN = 16 * MiB, WT_BA = 77 * MiB, WT_BD = 85 * MiB, WT_OUT = 93 * MiB, WT_UP = 101 * MiB, WT_DOWN = 145 * MiB;
constexpr size_t WS_XN = 168 * MiB;
constexpr size_t WS_QA = 296 * MiB;
constexpr size_t WS_KA = 424 * MiB, WS_VA = 456 * MiB;
constexpr size_t WS_QKVD = 488 * MiB;
constexpr size_t WS_ZD = 872 * MiB;
constexpr size_t WS_GA = 1000 * MiB, WS_GD = 1128 * MiB;
constexpr size_t WS_DN = 1256 * MiB;
constexpr size_t WS_HTAIL = 1640 * MiB;
constexpr size_t WS_END = 1834 * MiB;
constexpr int CW_BAR = 4096;
constexpr int CW_QUEUE = 16384;

constexpr int LDS_BYTES = 163840;
constexpr int MISC_OFF = 163840 - 256;

#define VM_WAIT() asm volatile("s_waitcnt vmcnt(0)" ::: "memory")
#define LDS_BARRIER() do { asm volatile("s_waitcnt lgkmcnt(0)" ::: "memory"); __builtin_amdgcn_s_barrier(); asm volatile("" ::: "memory"); } while (0)

#define XB_TMO      128
#define XB_XCNT(j)  (256  + 64 * (j))
#define XB_XSUB(j)  (1280 + 64 * (j))
#define XB_XGEN(j)  (2304 + 64 * (j))
#define XB_TOP      3328
#define XB_TOPGEN   3392
#define XCD_BAR_WORDS 3456
#define XB_SPIN_CAP (1u << 22)

__device__ __forceinline__ unsigned xb_ld(unsigned* p)              { return __hip_atomic_load(p, __ATOMIC_RELAXED, __HIP_MEMORY_SCOPE_AGENT); }
__device__ __forceinline__ unsigned xb_add(unsigned* p, unsigned v) { return __hip_atomic_fetch_add(p, v, __ATOMIC_RELAXED, __HIP_MEMORY_SCOPE_AGENT); }
__device__ __forceinline__ unsigned xb_xcc_id() { return (unsigned)__builtin_amdgcn_s_getreg((3 << 11) | 20) & 0xFu; }
#define XB_SPIN(cond, bar) do { unsigned _sp = 0; while (cond) { __builtin_amdgcn_s_sleep(1); \
    if ((++_sp & 255u) == 0u) { if (xb_ld(&(bar)[XB_TMO])) break; if (_sp > XB_SPIN_CAP) { atomicAdd(&(bar)[XB_TMO], 1u); break; } } } } while (0)

struct XcdBarrier {
    unsigned* bar; unsigned x;
    volatile LAS unsigned* st;
};
__device__ __forceinline__ XcdBarrier xcd_barrier_post(unsigned* bar, volatile LAS unsigned* st) {
    XcdBarrier b; b.bar = bar; b.x = xb_xcc_id(); b.st = st;
    if (threadIdx.x == 0) (void)xb_add(&bar[XB_XCNT(b.x)], 1u);
    return b;
}
__device__ __forceinline__ void xcd_barrier_complete(unsigned* bar, unsigned x, unsigned& nloc, unsigned& nx) {
    const unsigned G = gridDim.x * gridDim.y * gridDim.z;
    unsigned sum, cnt, mine, sp = 0u;
    for (;;) {
        sum = 0u; cnt = 0u; mine = 0u;
#pragma unroll
        for (unsigned j = 0; j < 16; ++j) { const unsigned c = xb_ld(&bar[XB_XCNT(j)]); sum += c; cnt += (c > 0u) ? 1u : 0u; mine = (j == x) ? c : mine; }
        if (sum == G) break;
        __builtin_amdgcn_s_sleep(1);
        if ((++sp & 255u) == 0u) { if (xb_ld(&bar[XB_TMO])) break; if (sp > XB_SPIN_CAP) { atomicAdd(&bar[XB_TMO], 1u); break; } }
    }
    nloc = mine > 0u ? mine : 1u; nx = cnt > 0u ? cnt : 1u;
}
__device__ __forceinline__ void xcd_barrier(const XcdBarrier& b) {
    asm volatile("s_waitcnt vmcnt(0)" ::: "memory");
    __syncthreads();
    if (threadIdx.x == 0) {
        unsigned* bar = b.bar;
        __builtin_amdgcn_s_waitcnt(0);
        unsigned nloc = b.st[0], nx = b.st[1];
        if (nloc == 0u) { xcd_barrier_complete(bar, b.x, nloc, nx); b.st[0] = nloc; b.st[1] = nx; }
        const unsigned old = xb_add(&bar[XB_XSUB(b.x)], 1u);
        const unsigned gen = old / nloc;
        if (old + 1u == (gen + 1u) * nloc) {
            __builtin_amdgcn_fence(__ATOMIC_RELEASE, "agent");
            asm volatile("s_waitcnt vmcnt(0)" ::: "memory");
            const unsigned og = xb_add(&bar[XB_TOP], 1u);
            const unsigned tg = og / nx;
            if (og + 1u == (tg + 1u) * nx) xb_add(&bar[XB_TOPGEN], 1u);
            else XB_SPIN(xb_ld(&bar[XB_TOPGEN]) == tg, bar);
            __builtin_amdgcn_fence(__ATOMIC_ACQUIRE, "agent");
            xb_add(&bar[XB_XGEN(b.x)], 1u);
            asm volatile("s_waitcnt vmcnt(0)" ::: "memory");
        } else {
            XB_SPIN(xb_ld(&bar[XB_XGEN(b.x)]) == gen, bar);
            __builtin_amdgcn_fence(__ATOMIC_ACQUIRE, "agent");
            asm volatile("s_waitcnt vmcnt(0)" ::: "memory");
        }
    }
    __syncthreads();
}

struct Args { const void* in[19]; float* out; unsigned char* ws; int ph_lo, ph_hi; };
struct Frame {
    LAS unsigned char* lds;
    int tid, lane, wave;
    unsigned char* ws;
    const float* x; const int* pos; float* out;
};

__device__ __forceinline__ float wave_sum(float v) {
#pragma unroll
    for (int o = 1; o < 64; o <<= 1) v += __shfl_xor(v, o);
    return v;
}
__device__ __forceinline__ float wave_max(float v) {
#pragma unroll
    for (int o = 1; o < 64; o <<= 1) v = fmaxf(v, __shfl_xor(v, o));
    return v;
}

__device__ __forceinline__ void transpose_item(const float* W, int K, int N, bf16_t* WT, LAS float* scr, int item, int lane, int remap) {
    const int nblk = N / 32, kb = item / nblk, nb = item % nblk, k0 = 64 * kb, n0 = 32 * nb;
    int n0d = n0;
    if (remap == 1) n0d = (n0 < 9216) ? n0 : ((n0 == 9216) ? 15360 : n0 - 32);
    if (remap == 2) { const int cch = (n0 < DFF) ? n0 : n0 - DFF; n0d = 256 * (cch >> 7) + ((n0 < DFF) ? 0 : 128) + (cch & 127); }
#pragma unroll 8
    for (int i = 0; i < 32; ++i) { const int kk = 2 * i + (lane >> 5); scr[kk * 33 + (lane & 31)] = W[(size_t)(k0 + kk) * N + n0 + (lane & 31)]; }
    asm volatile("s_waitcnt lgkmcnt(0)" ::: "memory");
    const int c = lane & 7;
#pragma unroll
    for (int j = 0; j < 4; ++j) { const int n = (lane >> 3) + 8 * j; const LAS float* s = scr + (8 * c) * 33 + n;
        u32x4 o; o.x = pk2(s[0 * 33], s[1 * 33]); o.y = pk2(s[2 * 33], s[3 * 33]); o.z = pk2(s[4 * 33], s[5 * 33]); o.w = pk2(s[6 * 33], s[7 * 33]);
        *(u32x4*)(WT + (size_t)(n0d + n) * K + k0 + 8 * c) = o; }
    asm volatile("s_waitcnt lgkmcnt(0)" ::: "memory");
}
__device__ __forceinline__ void ph_convert_weights(Frame& F, const __attribute__((address_space(4))) Args* a, int l) {
    LAS float* scr = (LAS float*)(F.lds + F.wave * 8448);
    const int gw = blockIdx.x * NWAVES + F.wave, NGW = gridDim.x * NWAVES;
    constexpr int I_IN = (D / 64) * (NIN_ORIG / 32), I_SQ = (D / 64) * (D / 32), I_UP = (D / 64) * (NUP / 32), I_DN = (DFF / 64) * (D / 32);
    constexpr int NITEMS = I_IN + 3 * I_SQ + I_UP + I_DN;
    const float* w_in = (const float*)a->in[3] + (size_t)l * D * NIN_ORIG;
    const float* w_ba = (const float*)a->in[9] + (size_t)l * D * D;
    const float* w_bd = (const float*)a->in[10] + (size_t)l * D * D;
    const float* w_out = (const float*)a->in[11] + (size_t)l * D * D;
    const float* w_up = (const float*)a->in[14] + (size_t)l * D * NUP;
    const float* w_dn = (const float*)a->in[17] + (size_t)l * DFF * D;
    for (int it = gw; it < NITEMS; it += NGW) {
        int r = it;
        if (r < I_IN) { transpose_item(w_in, D, NIN_ORIG, (bf16_t*)(F.ws + WT_IN), scr, r, F.lane, 1); continue; } r -= I_IN;
        if (r < I_SQ) { transpose_item(w_ba, D, D, (bf16_t*)(F.ws + WT_BA), scr, r, F.lane, 0); continue; } r -= I_SQ;
        if (r < I_SQ) { transpose_item(w_bd, D, D, (bf16_t*)(F.ws + WT_BD), scr, r, F.lane, 0); continue; } r -= I_SQ;
        if (r < I_SQ) { transpose_item(w_out, D, D, (bf16_t*)(F.ws + WT_OUT), scr, r, F.lane, 0); continue; } r -= I_SQ;
        if (r < I_UP) { transpose_item(w_up, D, NUP, (bf16_t*)(F.ws + WT_UP), scr, r, F.lane, 2); continue; } r -= I_UP;
        transpose_item(w_dn, DFF, D, (bf16_t*)(F.ws + WT_DOWN), scr, r, F.lane, 0);
    }
    { u32x4* z = (u32x4*)(F.ws + WT_IN + (size_t)NIN_ORIG * D * 2); const int n16 = (NIN - NIN_ORIG) * D * 2 / 16;
      for (int i = blockIdx.x * NTHREADS + F.tid; i < n16; i += gridDim.x * NTHREADS) z[i] = (u32x4){0u, 0u, 0u, 0u}; }
}

__device__ const float INV_FREQ[16] = {1.000000000e+00f, 4.403665960e-01f, 1.939227432e-01f, 8.539710194e-02f, 3.760603070e-02f, 1.656043902e-02f, 7.292664610e-03f, 3.211445874e-03f,
                                       1.414213562e-03f, 6.227723788e-04f, 2.742481884e-04f, 1.207697351e-04f, 5.318296098e-05f, 2.341999971e-05f, 1.031338616e-05f, 4.541670478e-06f};
__device__ __forceinline__ void ph_rope_table(Frame& F) {
    float* rope = (float*)(F.ws + WS_ROPE);
    for (int idx = blockIdx.x * NTHREADS + F.tid; idx < T * 16; idx += gridDim.x * NTHREADS) {
        const int t = idx >> 4, i = idx & 15;
        const float angf = (float)F.pos[t] * INV_FREQ[i];
        const double ang = (double)angf;
        const double TWO_PI = 6.283185307179586476925;
        const double r = ang - rint(ang / TWO_PI) * TWO_PI;
        const double r2 = r * r;
        double c = 1.0, s = r, tc = 1.0, ts = r;
#pragma unroll
        for (int k = 1; k <= 14; ++k) { tc *= -r2 / (double)((2 * k - 1) * (2 * k)); c += tc; ts *= -r2 / (double)((2 * k) * (2 * k + 1)); s += ts; }
        rope[(size_t)t * 32 + i] = (float)c; rope[(size_t)t * 32 + 16 + i] = (float)s;
    }
}

__device__ __forceinline__ void ph_norm_first(Frame& F, const float* x, const float* w, bf16_t* xn) {
    const int gw = blockIdx.x * NWAVES + F.wave, NGW = gridDim.x * NWAVES;
    for (int row = gw; row < T; row += NGW) {
        const float* xr = x + (size_t)row * D + 8 * F.lane;
        f32x4 v[4][2]; float ss = 0.f;
#pragma unroll
        for (int j = 0; j < 4; ++j) { v[j][0] = *(const f32x4*)(xr + 512 * j); v[j][1] = *(const f32x4*)(xr + 512 * j + 4);
#pragma unroll
            for (int e = 0; e < 4; ++e) ss += v[j][0][e] * v[j][0][e] + v[j][1][e] * v[j][1][e]; }
        const float rstd = 1.0f / sqrtf(wave_sum(ss) * (1.0f / D) + EPS);
#pragma unroll
        for (int j = 0; j < 4; ++j) { const f32x4 w0 = *(const f32x4*)(w + 512 * j + 8 * F.lane), w1 = *(const f32x4*)(w + 512 * j + 8 * F.lane + 4);
            const f32x4 a0 = v[j][0] * rstd * w0, a1 = v[j][1] * rstd * w1;
            u32x4 o; o.x = pk2(a0[0], a0[1]); o.y = pk2(a0[2], a0[3]); o.z = pk2(a1[0], a1[1]); o.w = pk2(a1[2], a1[3]);
            *(u32x4*)(xn + (size_t)row * D + 512 * j + 8 * F.lane) = o; }
    }
}
template <bool BB, bool OB>
__device__ __forceinline__ void ph_norm_res(Frame& F, const bf16_t* src, const float* w1, const void* basev, void* outv, const float* w2, bf16_t* xn) {
    const int gw = blockIdx.x * NWAVES + F.wave, NGW = gridDim.x * NWAVES;
    for (int row0 = gw; row0 < T; row0 += 2 * NGW) {
        u32x4 sraw[2][4]; u32x4 braw[2][4]; f32x4 bf[2][4][2];
#pragma unroll
        for (int r = 0; r < 2; ++r) { const int row = row0 + r * NGW; const bool ok = row < T; const size_t ro = (size_t)(ok ? row : row0) * D + 8 * F.lane;
#pragma unroll
            for (int j = 0; j < 4; ++j) { sraw[r][j] = *(const u32x4*)(src + ro + 512 * j);
                if (BB) braw[r][j] = *(const u32x4*)((const bf16_t*)basev + ro + 512 * j);
                else { bf[r][j][0] = *(const f32x4*)((const float*)basev + ro + 512 * j); bf[r][j][1] = *(const f32x4*)((const float*)basev + ro + 512 * j + 4); } } }
#pragma unroll
        for (int r = 0; r < 2; ++r) { const int row = row0 + r * NGW; if (row >= T) break;
            const size_t ro = (size_t)row * D + 8 * F.lane;
            f32x4 v[4][2]; float ss = 0.f;
#pragma unroll
            for (int j = 0; j < 4; ++j) { const u32x4 s = sraw[r][j];
                v[j][0][0] = bf_lo(s.x); v[j][0][1] = bf_hi(s.x); v[j][0][2] = bf_lo(s.y); v[j][0][3] = bf_hi(s.y);
                v[j][1][0] = bf_lo(s.z); v[j][1][1] = bf_hi(s.z); v[j][1][2] = bf_lo(s.w); v[j][1][3] = bf_hi(s.w);
#pragma unroll
                for (int e = 0; e < 4; ++e) ss += v[j][0][e] * v[j][0][e] + v[j][1][e] * v[j][1][e]; }
            const float rstd = __builtin_amdgcn_rsqf(wave_sum(ss) * (1.0f / D) + EPS);
            float ss2 = 0.f;
#pragma unroll
            for (int j = 0; j < 4; ++j) { const f32x4 w0 = *(const f32x4*)(w1 + 512 * j + 8 * F.lane), w1v = *(const f32x4*)(w1 + 512 * j + 8 * F.lane + 4);
                f32x4 b0, b1;
                if (BB) { const u32x4 s = braw[r][j];
                    b0[0] = bf_lo(s.x); b0[1] = bf_hi(s.x); b0[2] = bf_lo(s.y); b0[3] = bf_hi(s.y); b1[0] = bf_lo(s.z); b1[1] = bf_hi(s.z); b1[2] = bf_lo(s.w); b1[3] = bf_hi(s.w); }
                else { b0 = bf[r][j][0]; b1 = bf[r][j][1]; }
                v[j][0] = b0 + v[j][0] * rstd * w0; v[j][1] = b1 + v[j][1] * rstd * w1v;
                if (OB) { u32x4 o; o.x = pk2(v[j][0][0], v[j][0][1]); o.y = pk2(v[j][0][2], v[j][0][3]); o.z = pk2(v[j][1][0], v[j][1][1]); o.w = pk2(v[j][1][2], v[j][1][3]); *(u32x4*)((bf16_t*)outv + ro + 512 * j) = o; }
                else { *(f32x4*)((float*)outv + ro + 512 * j) = v[j][0]; *(f32x4*)((float*)outv + ro + 512 * j + 4) = v[j][1]; }
#pragma unroll
                for (int e = 0; e < 4; ++e) ss2 += v[j][0][e] * v[j][0][e] + v[j][1][e] * v[j][1][e]; }
            if (w2) {
                const float rstd2 = __builtin_amdgcn_rsqf(wave_sum(ss2) * (1.0f / D) + EPS);
#pragma unroll
                for (int j = 0; j < 4; ++j) { const f32x4 w0 = *(const f32x4*)(w2 + 512 * j + 8 * F.lane), w1v = *(const f32x4*)(w2 + 512 * j + 8 * F.lane + 4);
                    const f32x4 a0 = v[j][0] * rstd2 * w0, a1 = v[j][1] * rstd2 * w1v;
                    u32x4 o; o.x = pk2(a0[0], a0[1]); o.y = pk2(a0[2], a0[3]); o.z = pk2(a1[0], a1[1]); o.w = pk2(a1[2], a1[3]);
                    *(u32x4*)(xn + ro + 512 * j) = o; }
            }
        }
    }
}

__device__ __forceinline__ void ph_ffn_fixup(Frame& F, const float* PART, const float* TAIL, const float* cw, bf16_t* ACT) {
    constexpr int NQ = DFF / 4;
    for (int idx = blockIdx.x * NTHREADS + F.tid; idx < (T / 64) * 2 * NQ; idx += gridDim.x * NTHREADS) {
        const int q = idx % NQ, br = idx / NQ, r = br & 1, band = br >> 1, ch = 4 * q;
        f32x4 g = *(const f32x4*)(PART + (size_t)br * 11264 + ch), v = *(const f32x4*)(PART + (size_t)br * 11264 + 5632 + ch);
        if ((band & 63) != 0) {
            const float* t0 = TAIL + (size_t)((band - 1) * 2) * 11264 + ch; const float* t1 = t0 + 11264;
            const f32x4 w0g = *(const f32x4*)(cw + ch), w1g = *(const f32x4*)(cw + 11264 + ch), w0v = *(const f32x4*)(cw + 5632 + ch), w1v = *(const f32x4*)(cw + 11264 + 5632 + ch);
            const f32x4 t1g = *(const f32x4*)t1, t1v = *(const f32x4*)(t1 + 5632);
            if (r == 0) { const f32x4 t0g = *(const f32x4*)t0, t0v = *(const f32x4*)(t0 + 5632); g += w0g * t0g + w1g * t1g; v += w0v * t0v + w1v * t1v; }
            else { g += w0g * t1g; v += w0v * t1v; }
        }
        u32x2 o; o.x = pk2(siluf_(g[0]) * v[0], siluf_(g[1]) * v[1]); o.y = pk2(siluf_(g[2]) * v[2], siluf_(g[3]) * v[3]);
        *(u32x2*)(ACT + (size_t)(band * 64 + r) * DFF + ch) = o;
    }
}

typedef short bf16x8_t __attribute__((ext_vector_type(8)));
typedef short s16x4_t __attribute__((ext_vector_type(4)));
typedef float f32x16_t __attribute__((ext_vector_type(16)));
#define MFMA32(a, b, c) __builtin_amdgcn_mfma_f32_32x32x16_bf16((a), (b), (c), 0, 0, 0)
__device__ __forceinline__ s16x4_t lds_tr16(LAS unsigned char* p) { typedef short v4i16_t __attribute__((ext_vector_type(4))); return __builtin_bit_cast(s16x4_t, __builtin_amdgcn_ds_read_tr16_b64_v4i16((LAS v4i16_t*)p)); }
__device__ __forceinline__ void ph_attn(Frame& F, const bf16_t* QA, bf16_t* OA, const bf16_t* KA, const bf16_t* VA, const float* sinks, int first, int stride, int last) {
    LAS unsigned char* Ks = F.lds; LAS unsigned char* Vs = F.lds + 65536;
    const int lane = F.lane, w = F.wave, r = lane & 31, h = lane >> 5;
    const int vlane = ((4 * h + ((lane & 15) >> 2)) * 256) + (16 * ((lane >> 4) & 1) + 4 * (lane & 3)) * 2;
    for (int it = first; it < last; it += stride) {
        const int kvh = it & 3, blk = (it >> 2) & 31, b = it >> 7;
        const int t0 = b * SEQ + blk * 128;
        const int tk0 = (blk > 0) ? t0 - 128 : t0;
#pragma unroll
        for (int j = 0; j < 8; ++j) { const int cid = F.tid + 512 * j, key = cid >> 4, c16 = cid & 15;
            const int tok = (key < 128) ? tk0 + key : t0 + key - 128;
            const u32x4 kv = *(const u32x4*)(KA + (size_t)tok * 512 + kvh * 128 + c16 * 8), vv = *(const u32x4*)(VA + (size_t)tok * 512 + kvh * 128 + c16 * 8);
            *(LAS u32x4*)(Ks + key * 256 + ((c16 ^ (key & 15)) << 4)) = kv; *(LAS u32x4*)(Vs + key * 256 + c16 * 16) = vv; }
        LDS_BARRIER();
        const int hd = kvh * 4 + (w >> 1);
        const float sink = sinks[hd];
#pragma unroll 1
        for (int si = 0; si < 2; ++si) {
            const int s = 2 * (w & 1) + si;
            const bf16_t* qrow = QA + (size_t)(t0 + 32 * s + r) * 2048 + hd * 128; bf16_t* orow = OA + (size_t)(t0 + 32 * s + r) * 2048 + hd * 128;
            bf16x8_t qf[8];
#pragma unroll
            for (int ks = 0; ks < 8; ++ks) qf[ks] = *(const bf16x8_t*)(qrow + 16 * ks + 8 * h);
            f32x16_t S[5];
#pragma unroll
            for (int ct = 0; ct < 5; ++ct) { f32x16_t acc;
#pragma unroll
                for (int i = 0; i < 16; ++i) acc[i] = 0.f;
                const int key = 32 * (s + ct) + r;
#pragma unroll
                for (int ks = 0; ks < 8; ++ks) { const bf16x8_t kf = *(const LAS bf16x8_t*)(Ks + key * 256 + (((2 * ks + h) ^ (key & 15)) << 4)); acc = MFMA32(kf, qf[ks], acc); }
                S[ct] = acc; }
            const int qi = 32 * s + r;
            float mx = -__builtin_inff();
#pragma unroll
            for (int ct = 0; ct < 5; ++ct)
#pragma unroll
                for (int i = 0; i < 16; ++i) { const int c = 32 * (s + ct) + (i & 3) + 8 * (i >> 2) + 4 * h;
                    const bool valid = (c > qi) && (c <= qi + 128) && (blk > 0 || c >= 128);
                    const float v = valid ? S[ct][i] * 0.08838834764831845f : -__builtin_inff(); S[ct][i] = v; mx = fmaxf(mx, v); }
            mx = fmaxf(mx, __shfl_xor(mx, 32));
            const float m = fmaxf(mx, sink);
            float sum = 0.f;
#pragma unroll
            for (int ct = 0; ct < 5; ++ct)
#pragma unroll
                for (int i = 0; i < 16; ++i) { const float p = __expf(S[ct][i] - m); S[ct][i] = p; sum += p; }
            sum += __shfl_xor(sum, 32);
            const float inv = 1.0f / (sum + __expf(sink - m));
            f32x16_t O[4];
#pragma unroll
            for (int dt = 0; dt < 4; ++dt)
#pragma unroll
                for (int i = 0; i < 16; ++i) O[dt][i] = 0.f;
#pragma unroll
            for (int ct = 0; ct < 5; ++ct)
#pragma unroll
                for (int s2 = 0; s2 < 2; ++s2) {
                    u32x4 pw; pw.x = pk2(S[ct][8 * s2 + 0], S[ct][8 * s2 + 1]); pw.y = pk2(S[ct][8 * s2 + 2], S[ct][8 * s2 + 3]); pw.z = pk2(S[ct][8 * s2 + 4], S[ct][8 * s2 + 5]); pw.w = pk2(S[ct][8 * s2 + 6], S[ct][8 * s2 + 7]);
                    const bf16x8_t pf = __builtin_bit_cast(bf16x8_t, pw);
                    LAS unsigned char* vb = Vs + vlane + (32 * (s + ct) + 16 * s2) * 256;
#pragma unroll
                    for (int dt = 0; dt < 4; ++dt) { const s16x4_t va = lds_tr16(vb + dt * 64), vc = lds_tr16(vb + dt * 64 + 2048);
                        const bf16x8_t vf = __builtin_shufflevector(va, vc, 0, 1, 2, 3, 4, 5, 6, 7);
                        O[dt] = MFMA32(vf, pf, O[dt]); }
                }
#pragma unroll
            for (int dt = 0; dt < 4; ++dt)
#pragma unroll
                for (int gq = 0; gq < 4; ++gq) { u32x2 o; o.x = pk2(O[dt][4 * gq] * inv, O[dt][4 * gq + 1] * inv); o.y = pk2(O[dt][4 * gq + 2] * inv, O[dt][4 * gq + 3] * inv);
                    *(u32x2*)(orow + 32 * dt + 8 * gq + 4 * h) = o; }
        }
        LDS_BARRIER();
    }
}

#ifndef DUP_S1
#define DUP_S1 1
#endif
#ifndef DUP_S2
#define DUP_S2 1
#endif
#ifndef DUP_S3
#define DUP_S3 1
#endif
#ifndef DUP_S5
#define DUP_S5 1
#endif
#ifndef DUP_SOLVE
#define DUP_SOLVE 0
#endif
constexpr int DR_W = 0, DR_QG = 16384, DR_KG = 32768, DR_QK = 49152, DR_DL = 55296, DR_U = 55552, DR_BYTES = 72192;
#ifndef SCAN_AUX
#define SCAN_AUX 0
#endif
constexpr int DN_LBUF = 57344;
#define MFMA16(a, b, c) __builtin_amdgcn_mfma_f32_16x16x32_bf16((a), (b), (c), 0, 0, 0)
__device__ __forceinline__ int tsw(int row, int col) { return row * 272 + col * 2; }
__device__ __forceinline__ bf16_t bf16r(float v) { return (bf16_t)(pk2(v, 0.f) & 0xffffu); }
__device__ __forceinline__ void unpack8(const u32x4 w, float* o) { o[0] = bf_lo(w.x); o[1] = bf_hi(w.x); o[2] = bf_lo(w.y); o[3] = bf_hi(w.y); o[4] = bf_lo(w.z); o[5] = bf_hi(w.z); o[6] = bf_lo(w.w); o[7] = bf_hi(w.w); }
__device__ __forceinline__ bf16x8_t packstep(const f32x16_t& X, const int s) { u32x4 p; p.x = pk2(X[8 * s], X[8 * s + 1]); p.y = pk2(X[8 * s + 2], X[8 * s + 3]); p.z = pk2(X[8 * s + 4], X[8 * s + 5]); p.w = pk2(X[8 * s + 6], X[8 * s + 7]); return __builtin_bit_cast(bf16x8_t, p); }

__device__ __forceinline__ bf16x8_t mk_b(const f32x4 p, const f32x4 q) { u32x4 w; w.x = pk2(p[0], p[1]); w.y = pk2(p[2], p[3]); w.z = pk2(q[0], q[1]); w.w = pk2(q[2], q[3]); return __builtin_bit_cast(bf16x8_t, w); }
__device__ __forceinline__ bf16x8_t mk_a(const u32x2 p, const u32x2 q) { u32x4 w; w.x = p.x; w.y = p.y; w.z = q.x; w.w = q.y; return __builtin_bit_cast(bf16x8_t, w); }
__device__ __forceinline__ void ph_dn_prep(Frame& F, const bf16_t* QKVD, const float* BAf, const float* convw, const float* a_log, const float* dt_bias, unsigned char* DN) {
    const int hb = F.tid >> 8, lw = (F.tid >> 6) & 3, lane = F.lane;
    int ltid = F.tid & 255;
#define DN_LAUNDER() asm volatile("" : "+v"(ltid))
    LAS unsigned char* HB = F.lds + hb * 75776;
    LAS unsigned char* QH = HB; LAS unsigned char* KH = HB + 17408; LAS unsigned char* VH = HB + 34816;
    LAS float* AD = (LAS float*)(HB + 52224);
    LAS unsigned char* ABF = HB + 56320;
    LAS unsigned char* QKS = HB + 64512;
    LAS unsigned char* TIB = HB + 72704;
    LAS float* SC = (LAS float*)(HB + 74752);
    volatile LAS unsigned* hcnt = (volatile LAS unsigned*)(F.lds + MISC_OFF + 64 + 64 * hb);
    if (ltid == 0) *hcnt = 0u;
    LDS_BARRIER();
#define HALF_BARRIER() do { asm volatile("s_waitcnt lgkmcnt(0)" ::: "memory"); unsigned old_ = 0u; \
        if (lane == 0) old_ = __hip_atomic_fetch_add((LAS unsigned*)hcnt, 1u, __ATOMIC_RELAXED, __HIP_MEMORY_SCOPE_WORKGROUP); \
        const unsigned tgt_ = ((unsigned)__builtin_amdgcn_readfirstlane((int)old_) & ~3u) + 4u; unsigned sp_ = 0u; \
        while ((unsigned)__builtin_amdgcn_readfirstlane((int)*hcnt) < tgt_) { __builtin_amdgcn_s_sleep(1); if (++sp_ > (1u << 22)) break; } \
        asm volatile("" ::: "memory"); } while (0)
    u32x4 xr[3][7];
#define DN_LOADRAW(IT) do { const int hp_ = (IT) & 7, cidx_ = (IT) >> 3, h_ = 2 * hp_ + hb, n_ = cidx_ & 63; const int cg_ = ltid & 15, rs_ = ltid >> 4; \
        _Pragma("unroll") for (int sec_ = 0; sec_ < 3; ++sec_) { const int col_ = sec_ * 2048 + h_ * 128 + 8 * cg_; \
            _Pragma("unroll") for (int k_ = 0; k_ < 7; ++k_) { const int rloc_ = 4 * rs_ - 3 + k_; \
                if (n_ * 64 + rloc_ >= 0) xr[sec_][k_] = *(const u32x4*)(QKVD + (size_t)(cidx_ * 64 + rloc_) * 6144 + col_); else xr[sec_][k_] = (u32x4){0u, 0u, 0u, 0u}; } } } while (0)
    for (int it = blockIdx.x; it < NB * 64 * 8; it += gridDim.x) {
        const int hp = it & 7, cidx = it >> 3, h = 2 * hp + hb, b = cidx >> 6, n = cidx & 63;
        const int tb = cidx * 64;
        unsigned char* rec = DN + (size_t)((b * 16 + h) * 64 + n) * DR_BYTES;
        DN_LAUNDER();
        DN_LOADRAW(it);
        { const int cg = ltid & 15, rs = ltid >> 4;
#pragma unroll
          for (int sec = 0; sec < 3; ++sec) {
              const int col = sec * 2048 + h * 128 + 8 * cg;
              float wv[4][8];
#pragma unroll
              for (int j = 0; j < 4; ++j) { const f32x4 a0 = *(const f32x4*)(convw + j * 6144 + col), a1 = *(const f32x4*)(convw + j * 6144 + col + 4);
#pragma unroll
                  for (int e = 0; e < 4; ++e) { wv[j][e] = a0[e]; wv[j][4 + e] = a1[e]; } }
              LAS unsigned char* tile = (sec == 0) ? QH : ((sec == 1) ? KH : VH);
#pragma unroll
              for (int rr = 0; rr < 4; ++rr) { float o[8]; float ss = 0.f; float x0[8], x1[8], x2[8], x3[8]; unpack8(xr[sec][rr], x0); unpack8(xr[sec][rr + 1], x1); unpack8(xr[sec][rr + 2], x2); unpack8(xr[sec][rr + 3], x3);
#pragma unroll
                  for (int e = 0; e < 8; ++e) { const float a = wv[0][e] * x0[e] + wv[1][e] * x1[e] + wv[2][e] * x2[e] + wv[3][e] * x3[e]; o[e] = siluf_(a); ss += o[e] * o[e]; }
                  if (sec < 2) { ss += __shfl_xor(ss, 1); ss += __shfl_xor(ss, 2); ss += __shfl_xor(ss, 4); ss += __shfl_xor(ss, 8);
                      const float sc = __builtin_amdgcn_rsqf(ss + 1e-6f) * ((sec == 0) ? 0.08838834764831845f : 1.0f);
#pragma unroll
                      for (int e = 0; e < 8; ++e) o[e] *= sc; }
                  u32x4 pw; pw.x = pk2(o[0], o[1]); pw.y = pk2(o[2], o[3]); pw.z = pk2(o[4], o[5]); pw.w = pk2(o[6], o[7]);
                  *(LAS u32x4*)(tile + tsw(4 * rs + rr, 8 * cg)) = pw; }
              __builtin_amdgcn_sched_barrier(0);
          } }
        if (lw == 0) { const int i = lane; const size_t tok = (size_t)tb + i;
            const float bd = BAf[tok * 32 + h], ad = BAf[tok * 32 + 16 + h];
            const float xs = ad + dt_bias[h]; const float sp = (xs > 20.f) ? xs : log1pf(__expf(xs));
            float gc = -__expf(a_log[h]) * sp;
            int ln = lane; asm volatile("" : "+v"(ln));
#pragma unroll
            for (int o = 1; o < 64; o <<= 1) { const int src = (ln >= o) ? ln - o : ln; const float t = __builtin_bit_cast(float, __builtin_amdgcn_ds_bpermute(src << 2, __builtin_bit_cast(int, gc))); if (ln >= o) gc += t; }
            const float gl = __builtin_bit_cast(float, __builtin_amdgcn_readlane(__builtin_bit_cast(int, gc), 63));
            SC[i] = sigmoidf_(bd); SC[64 + i] = gc; SC[128 + i] = __expf(gc); SC[192 + i] = __expf(gl - gc);
            if (lane == 0) *(float*)(rec + DR_DL) = __expf(gl); }
        HALF_BARRIER();
        { const int I = lw, fr = lane & 15, fq = lane >> 4;
          bf16x8_t ak[4], aq[4];
#pragma unroll
          for (int ks = 0; ks < 4; ++ks) { ak[ks] = *(const LAS bf16x8_t*)(KH + tsw(16 * I + fr, 32 * ks + 8 * fq)); aq[ks] = *(const LAS bf16x8_t*)(QH + tsw(16 * I + fr, 32 * ks + 8 * fq)); }
          float gci[4], bti[4];
#pragma unroll
          for (int q = 0; q < 4; ++q) { gci[q] = SC[64 + 16 * I + 4 * fq + q]; bti[q] = SC[16 * I + 4 * fq + q]; }
#pragma unroll
          for (int J = 0; J < 4; ++J) { f32x4 ckk = {0.f, 0.f, 0.f, 0.f}, cqk = ckk;
#pragma unroll
              for (int ks = 0; ks < 4; ++ks) { const bf16x8_t bfr = *(const LAS bf16x8_t*)(KH + tsw(16 * J + fr, 32 * ks + 8 * fq)); ckk = MFMA16(ak[ks], bfr, ckk); cqk = MFMA16(aq[ks], bfr, cqk); }
              const int j = 16 * J + fr; const float gcj = SC[64 + j];
#pragma unroll
              for (int q = 0; q < 4; ++q) { const int i = 16 * I + 4 * fq + q; const float ex = __expf(fminf(gci[q] - gcj, 0.f));
                  const float av = (j < i) ? bti[q] * ckk[q] * ex : 0.f;
                  *(LAS bf16_t*)(ABF + (i * 64 + j) * 2) = bf16r(-av);
                  if (J == I) AD[I * 256 + (4 * fq + q) * 16 + fr] = av;
                  *(LAS bf16_t*)(QKS + (i * 64 + j) * 2) = bf16r((j <= i) ? cqk[q] * ex : 0.f); } } }
        HALF_BARRIER();
        DN_LAUNDER();
#pragma unroll
        for (int q4 = 0; q4 < 4; ++q4) { const int p = ltid + 256 * q4, mk = p >> 6, lp = p & 63, hh = lp >> 5, rr = lp & 31, mt = mk >> 3, ks = mk & 7, row = 32 * mt + rr;
            const u32x2 a = *(const LAS u32x2*)(QH + tsw(row, 16 * ks + 4 * hh)), b2 = *(const LAS u32x2*)(QH + tsw(row, 16 * ks + 8 + 4 * hh));
            const float sc = SC[128 + row];
            u32x4 o; o.x = pk2(bf_lo(a.x) * sc, bf_hi(a.x) * sc); o.y = pk2(bf_lo(a.y) * sc, bf_hi(a.y) * sc); o.z = pk2(bf_lo(b2.x) * sc, bf_hi(b2.x) * sc); o.w = pk2(bf_lo(b2.y) * sc, bf_hi(b2.y) * sc);
            __builtin_nontemporal_store(o, (u32x4*)(rec + DR_QG + p * 16)); }
#pragma unroll
        for (int q4 = 0; q4 < 4; ++q4) { const int p = ltid + 256 * q4, mk = p >> 6, lp = p & 63, hh = lp >> 5, rr = lp & 31, mt = mk >> 2, ks = mk & 3, d = 32 * mt + rr;
            float v[8];
#pragma unroll
            for (int j = 0; j < 8; ++j) { const int cc = 16 * ks + 8 * (j >> 2) + 4 * hh + (j & 3); v[j] = bf1(*(const LAS bf16_t*)(KH + tsw(cc, d))) * SC[192 + cc]; }
            u32x4 o; o.x = pk2(v[0], v[1]); o.y = pk2(v[2], v[3]); o.z = pk2(v[4], v[5]); o.w = pk2(v[6], v[7]);
            __builtin_nontemporal_store(o, (u32x4*)(rec + DR_KG + p * 16)); }
#pragma unroll
        for (int q2 = 0; q2 < 2; ++q2) { const int p = ltid + 256 * q2, mk = p >> 6, lp = p & 63, hh = lp >> 5, rr = lp & 31, mt = mk >> 2, ks = mk & 3, i = 32 * mt + rr;
            if (mt == 0 && ks >= 2) continue;
            const u32x2 a = *(const LAS u32x2*)(QKS + (i * 64 + 16 * ks + 4 * hh) * 2), b2 = *(const LAS u32x2*)(QKS + (i * 64 + 16 * ks + 8 + 4 * hh) * 2);
            u32x4 o; o.x = a.x; o.y = a.y; o.z = b2.x; o.w = b2.y;
            __builtin_nontemporal_store(o, (u32x4*)(rec + DR_QK + ((mt == 0 ? ks : 2 + ks) * 64 + lp) * 16)); }
        if (lw == 0) { const int I = lane >> 4, cc = lane & 15; const LAS float* ad = AD + I * 256;
            float t[16];
#pragma unroll
            for (int i = 0; i < 16; ++i) { float s = 0.f;
#pragma unroll
                for (int j = 0; j < i; ++j) s += ad[i * 16 + j] * t[j];
                t[i] = ((i == cc) ? 1.f : 0.f) - s; }
#pragma unroll
            for (int m = 0; m < 16; ++m) *(LAS bf16_t*)(TIB + ((I * 16 + m) * 16 + cc) * 2) = bf16r(t[m]); }
        HALF_BARRIER();
        DN_LAUNDER();
        { const int fr = lane & 15, fq = lane >> 4;
          const u32x2 z2 = {0u, 0u}; const f32x4 z4 = {0.f, 0.f, 0.f, 0.f};
          bf16x8_t aT[4], a10, a2x, a3x, a32;
#pragma unroll
          for (int I = 0; I < 4; ++I) aT[I] = mk_a(*(const LAS u32x2*)(TIB + ((I * 16 + fr) * 16 + 4 * fq) * 2), z2);
          a10 = mk_a(*(const LAS u32x2*)(ABF + ((16 + fr) * 64 + 4 * fq) * 2), z2);
          a2x = mk_a(*(const LAS u32x2*)(ABF + ((32 + fr) * 64 + 4 * fq) * 2), *(const LAS u32x2*)(ABF + ((32 + fr) * 64 + 16 + 4 * fq) * 2));
          a3x = mk_a(*(const LAS u32x2*)(ABF + ((48 + fr) * 64 + 4 * fq) * 2), *(const LAS u32x2*)(ABF + ((48 + fr) * 64 + 16 + 4 * fq) * 2));
          a32 = mk_a(*(const LAS u32x2*)(ABF + ((48 + fr) * 64 + 32 + 4 * fq) * 2), z2);
          float bt[4][4], eg[4][4];
#pragma unroll
          for (int I = 0; I < 4; ++I)
#pragma unroll
              for (int q = 0; q < 4; ++q) { bt[I][q] = SC[16 * I + 4 * fq + q]; eg[I][q] = SC[128 + 16 * I + 4 * fq + q]; }
#pragma unroll 1
          for (int pass = 0; pass < 2; ++pass) {
#pragma unroll
              for (int tt = 0; tt < 2; ++tt) { const int col = 16 * (2 * lw + tt) + fr;
                  f32x4 R[4];
#pragma unroll
                  for (int I = 0; I < 4; ++I)
#pragma unroll
                      for (int q = 0; q < 4; ++q) { const int row = 16 * I + 4 * fq + q;
                          R[I][q] = (pass == 0) ? -bf1(*(const LAS bf16_t*)(KH + tsw(row, col))) * bt[I][q] * eg[I][q] : bf1(*(const LAS bf16_t*)(VH + tsw(row, col))) * bt[I][q]; }
                  const f32x4 X0 = MFMA16(aT[0], mk_b(R[0], z4), z4);
                  const f32x4 E1 = MFMA16(a10, mk_b(X0, z4), R[1]);
                  const f32x4 X1 = MFMA16(aT[1], mk_b(E1, z4), z4);
                  const f32x4 E2 = MFMA16(a2x, mk_b(X0, X1), R[2]);
                  const f32x4 X2 = MFMA16(aT[2], mk_b(E2, z4), z4);
                  f32x4 E3 = MFMA16(a3x, mk_b(X0, X1), R[3]);
                  E3 = MFMA16(a32, mk_b(X2, z4), E3);
                  const f32x4 X3 = MFMA16(aT[3], mk_b(E3, z4), z4);
                  if (pass == 0) {
#pragma unroll
                      for (int q = 0; q < 4; ++q) { *(LAS bf16_t*)(QH + tsw(4 * fq + q, col)) = bf16r(X0[q]); *(LAS bf16_t*)(QH + tsw(16 + 4 * fq + q, col)) = bf16r(X1[q]);
                          *(LAS bf16_t*)(QH + tsw(32 + 4 * fq + q, col)) = bf16r(X2[q]); *(LAS bf16_t*)(QH + tsw(48 + 4 * fq + q, col)) = bf16r(X3[q]); }
                  } else {
                      u32x2 o; o.x = pk2(X0[0], X0[1]); o.y = pk2(X0[2], X0[3]); *(LAS u32x2*)(KH + col * 128 + (4 * fq) * 2) = o;
                      o.x = pk2(X1[0], X1[1]); o.y = pk2(X1[2], X1[3]); *(LAS u32x2*)(KH + col * 128 + (16 + 4 * fq) * 2) = o;
                      o.x = pk2(X2[0], X2[1]); o.y = pk2(X2[2], X2[3]); *(LAS u32x2*)(KH + col * 128 + (32 + 4 * fq) * 2) = o;
                      o.x = pk2(X3[0], X3[1]); o.y = pk2(X3[2], X3[3]); *(LAS u32x2*)(KH + col * 128 + (48 + 4 * fq) * 2) = o; }
              }
              if (pass == 0) HALF_BARRIER();
          } }
        HALF_BARRIER();
        DN_LAUNDER();
#pragma unroll
        for (int q4 = 0; q4 < 4; ++q4) { const int p = ltid + 256 * q4, mk = p >> 6, lp = p & 63, hh = lp >> 5, rr = lp & 31, mt = mk >> 3, ks = mk & 7, row = 32 * mt + rr;
            const u32x2 a = *(const LAS u32x2*)(QH + tsw(row, 16 * ks + 4 * hh)), b2 = *(const LAS u32x2*)(QH + tsw(row, 16 * ks + 8 + 4 * hh));
            u32x4 o; o.x = a.x; o.y = a.y; o.z = b2.x; o.w = b2.y;
            __builtin_nontemporal_store(o, (u32x4*)(rec + DR_W + p * 16)); }
#pragma unroll
        for (int q2 = 0; q2 < 2; ++q2) { const int p = ltid + 256 * q2, mk = p >> 6, lp = p & 63, hh = lp >> 5, rr = lp & 31, ct = mk >> 2, et = mk & 3, e = 32 * et + rr;
            u32x2 g[4];
#pragma unroll
            for (int gq = 0; gq < 4; ++gq) g[gq] = *(const LAS u32x2*)(KH + e * 128 + (32 * ct + 8 * gq + 4 * hh) * 2);
            u32x4 o0, o1; o0.x = g[0].x; o0.y = g[0].y; o0.z = g[1].x; o0.w = g[1].y; o1.x = g[2].x; o1.y = g[2].y; o1.z = g[3].x; o1.w = g[3].y;
            __builtin_nontemporal_store(o0, (u32x4*)(rec + DR_U + p * 32)); __builtin_nontemporal_store(o1, (u32x4*)(rec + DR_U + p * 32 + 16)); }
        HALF_BARRIER();
    }
    LDS_BARRIER();
#undef DN_LAUNDER
#undef HALF_BARRIER
#undef DN_LOADRAW
}

__device__ __forceinline__ void dn_epilogue(int t2, LAS unsigned char* Ob  , const u32x4 (&zr)[4], const LAS float* nwl  , bf16_t* OD, int tok0, int h) {
    const int c = t2 >> 2, cq = t2 & 3;
    float ss = 0.f;
#pragma unroll
    for (int k = 0; k < 4; ++k) { float t[8]; unpack8(*(const LAS u32x4*)(Ob + (c * 128 + 32 * cq + 8 * k) * 2), t);
#pragma unroll
        for (int e = 0; e < 8; ++e) ss += t[e] * t[e]; }
    asm volatile("" ::: "memory");
    ss += __shfl_xor(ss, 1); ss += __shfl_xor(ss, 2);
    const float rstd = __builtin_amdgcn_rsqf(ss * (1.0f / 128.f) + EPS);
    bf16_t* op = OD + (size_t)(tok0 + c) * 2048 + h * 128 + 32 * cq;
#pragma unroll
    for (int k2 = 0; k2 < 4; ++k2) { float z[8], ov[8]; unpack8(zr[k2], z); unpack8(*(const LAS u32x4*)(Ob + (c * 128 + 32 * cq + 8 * k2) * 2), ov);
        float y[8];
        const f32x4 n0 = *(const LAS f32x4*)(nwl + 32 * cq + 8 * k2), n1 = *(const LAS f32x4*)(nwl + 32 * cq + 8 * k2 + 4);
#pragma unroll
        for (int e = 0; e < 4; ++e) { y[e] = ov[e] * rstd * n0[e] * siluf_(z[e]); y[4 + e] = ov[4 + e] * rstd * n1[e] * siluf_(z[4 + e]); }
        u32x4 o; o.x = pk2(y[0], y[1]); o.y = pk2(y[2], y[3]); o.z = pk2(y[4], y[5]); o.w = pk2(y[6], y[7]);
        *(u32x4*)(op + 8 * k2) = o; }
}
__device__ __forceinline__ void ph_dn_scan(Frame& F, int it, const bf16_t* ZD, bf16_t* OD, const float* norm_w, const unsigned char* DN) {
    const int b = it >> 4, h = it & 15, lane = F.lane, w = F.wave;
    const unsigned char* recs = DN + (size_t)((b * 16 + h) * 64) * DR_BYTES;
    const __amdgpu_buffer_rsrc_t rsrc = __builtin_amdgcn_make_buffer_rsrc((void*)recs, 0, 64 * DR_BYTES, 0x00020000);
#define BLD16(voff, soff) __builtin_bit_cast(u32x4, __builtin_amdgcn_raw_buffer_load_b128(rsrc, (voff), (soff), SCAN_AUX))
    LAS unsigned char* Ob = F.lds + 2 * DN_LBUF;
    if (w < 4) {
        f32x16_t S[4];
#pragma unroll
        for (int dt = 0; dt < 4; ++dt)
#pragma unroll
            for (int i = 0; i < 16; ++i) S[dt][i] = 0.f;
        u32x4 uA[2][2], uB[2][2];
#pragma unroll
        for (int ct = 0; ct < 2; ++ct) { uA[ct][0] = BLD16(lane * 32, DR_U + (ct * 4 + w) * 2048); uA[ct][1] = BLD16(lane * 32 + 16, DR_U + (ct * 4 + w) * 2048);
            uB[ct][0] = BLD16(lane * 32, DR_BYTES + DR_U + (ct * 4 + w) * 2048); uB[ct][1] = BLD16(lane * 32 + 16, DR_BYTES + DR_U + (ct * 4 + w) * 2048); }
        LDS_BARRIER();
#define SC_CHUNK(n, UU) do { \
            int lv = lane; asm volatile("" : "+v"(lv));     \
            LAS unsigned char* buf = F.lds + ((n) & 1) * DN_LBUF; \
            const float dl = *(const LAS float*)(buf + DR_DL); \
            f32x16_t v[2], o[2]; \
            _Pragma("unroll") for (int ct = 0; ct < 2; ++ct) { float t0[8], t1[8]; unpack8(UU[ct][0], t0); unpack8(UU[ct][1], t1); \
                _Pragma("unroll") for (int i = 0; i < 8; ++i) { v[ct][i] = t0[i]; v[ct][8 + i] = t1[i]; o[ct][i] = 0.f; o[ct][8 + i] = 0.f; } } \
            if ((n) + 2 < 64) {                              \
                _Pragma("unroll") for (int ct = 0; ct < 2; ++ct) { UU[ct][0] = BLD16(lv * 32, ((n) + 2) * DR_BYTES + DR_U + (ct * 4 + w) * 2048); UU[ct][1] = BLD16(lv * 32 + 16, ((n) + 2) * DR_BYTES + DR_U + (ct * 4 + w) * 2048); } } \
              \
            bf16x8_t fa[2][4], fb[2][3]; \
            SC_LDA(0); \
            _Pragma("unroll") for (int ks = 0; ks < 8; ++ks) {                 \
                if (ks + 1 < 8) SC_LDA(ks + 1); else SC_LDB(0, 0); \
                __builtin_amdgcn_sched_barrier(0); \
                const bf16x8_t sp = packstep(S[ks >> 1], ks & 1); \
                _Pragma("unroll") for (int ct = 0; ct < 2; ++ct) { v[ct] = MFMA32(fa[ks & 1][2 * ct], sp, v[ct]); o[ct] = MFMA32(fa[ks & 1][2 * ct + 1], sp, o[ct]); } \
                __builtin_amdgcn_sched_barrier(0); } \
            _Pragma("unroll") for (int dt = 0; dt < 4; ++dt) _Pragma("unroll") for (int i = 0; i < 16; ++i) S[dt][i] *= dl; \
            _Pragma("unroll") for (int k2 = 0; k2 < 4; ++k2) {                 \
                const bf16x8_t vp = packstep(v[k2 >> 1], k2 & 1); \
                SC_LDB(k2, 1); \
                __builtin_amdgcn_sched_barrier(0); \
                if (k2 < 2) o[0] = MFMA32(fb[0][0], vp, o[0]);                \
                o[1] = MFMA32(fb[0][1], vp, o[1]); S[0] = MFMA32(fb[0][2], vp, S[0]); \
                __builtin_amdgcn_sched_barrier(0); \
                if (k2 + 1 < 4) SC_LDB(k2 + 1, 0); \
                __builtin_amdgcn_sched_barrier(0); \
                S[1] = MFMA32(fb[1][0], vp, S[1]); S[2] = MFMA32(fb[1][1], vp, S[2]); S[3] = MFMA32(fb[1][2], vp, S[3]); \
                __builtin_amdgcn_sched_barrier(0); } \
            { LAS unsigned char* ob = Ob + ((n) & 1) * 16384; \
              _Pragma("unroll") for (int ct = 0; ct < 2; ++ct) _Pragma("unroll") for (int i = 0; i < 16; ++i) \
                  *(LAS bf16_t*)(ob + ((32 * ct + (i & 3) + 8 * (i >> 2) + 4 * (lv >> 5)) * 128 + 32 * w + (lv & 31)) * 2) = bf16r(o[ct][i]); } \
            LDS_BARRIER();                                  \
        } while (0)
#define SC_LDA(ks) do { _Pragma("unroll") for (int ct_ = 0; ct_ < 2; ++ct_) { fa[(ks) & 1][2 * ct_] = *(const LAS bf16x8_t*)(buf + DR_W + ((ct_ * 8 + (ks)) * 64 + lv) * 16); fa[(ks) & 1][2 * ct_ + 1] = *(const LAS bf16x8_t*)(buf + DR_QG + ((ct_ * 8 + (ks)) * 64 + lv) * 16); } } while (0)
#define SC_LDB(k2, hf) do { if ((hf) == 0) { if ((k2) < 2) fb[0][0] = *(const LAS bf16x8_t*)(buf + DR_QK + ((k2) * 64 + lv) * 16); fb[0][1] = *(const LAS bf16x8_t*)(buf + DR_QK + ((2 + (k2)) * 64 + lv) * 16); \
                fb[0][2] = *(const LAS bf16x8_t*)(buf + DR_KG + ((0 * 4 + (k2)) * 64 + lv) * 16); } \
            else { _Pragma("unroll") for (int dt_ = 1; dt_ < 4; ++dt_) fb[1][dt_ - 1] = *(const LAS bf16x8_t*)(buf + DR_KG + ((dt_ * 4 + (k2)) * 64 + lv) * 16); } } while (0)
#pragma unroll 1
        for (int n = 0; n < 64; n += 2) { SC_CHUNK(n, uA); SC_CHUNK(n + 1, uB); }
#undef SC_CHUNK
#undef SC_LDA
#undef SC_LDB
        LDS_BARRIER();
    } else {
        const int t2 = F.tid - 256, sg = t2 >> 7, tg = t2 & 127;
        u32x4 stg[28];
        if (sg == 0) {
#pragma unroll
            for (int k = 0; k < 28; ++k) stg[k] = BLD16(tg * 16, 2048 * k);
#pragma unroll
            for (int k = 0; k < 28; ++k) *(LAS u32x4*)(F.lds + (tg + 128 * k) * 16) = stg[k];
            asm volatile("s_waitcnt lgkmcnt(0)" ::: "memory"); __builtin_amdgcn_sched_barrier(0);
#pragma unroll
            for (int k = 0; k < 28; ++k) stg[k] = BLD16(tg * 16, 2 * DR_BYTES + 2048 * k);
        } else {
#pragma unroll
            for (int k = 0; k < 28; ++k) stg[k] = BLD16(tg * 16, DR_BYTES + 2048 * k);
        }
        LAS float* nwl = (LAS float*)(F.lds + 2 * DN_LBUF + 32768);
        if (t2 < 32) *(LAS f32x4*)(nwl + 4 * t2) = *(const f32x4*)(norm_w + 4 * t2);
        LDS_BARRIER();
#define SC_STAGE(n, GRP) do { \
            int t2v = t2; asm volatile("" : "+v"(t2v));     \
            u32x4 zr[4];                                     \
            { const bf16_t* zp_ = ZD + (size_t)(b * SEQ + ((n) > 0 ? (n) - 1 : 0) * 64 + (t2v >> 2)) * 2048 + h * 128 + 32 * (t2v & 3); \
              _Pragma("unroll") for (int k = 0; k < 4; ++k) zr[k] = *(const u32x4*)(zp_ + 8 * k); } \
            if (sg == (GRP)) {                               \
                if ((n) + 1 < 64) { LAS unsigned char* nb = F.lds + (((n) + 1) & 1) * DN_LBUF; \
                    _Pragma("unroll") for (int k = 0; k < 28; ++k) *(LAS u32x4*)(nb + (tg + 128 * k) * 16) = stg[k]; } \
                if ((n) + 3 < 64) { \
                    _Pragma("unroll") for (int k = 0; k < 28; ++k) stg[k] = BLD16(tg * 16, ((n) + 3) * DR_BYTES + 2048 * k); } } \
            if ((n) > 0) dn_epilogue(t2v, Ob + (((n) - 1) & 1) * 16384, zr, nwl, OD, b * SEQ + ((n) - 1) * 64, h); \
            LDS_BARRIER();                                   \
        } while (0)
#pragma unroll 1
        for (int n = 0; n < 64; n += 2) { SC_STAGE(n, 1); SC_STAGE(n + 1, 0); }
#undef SC_STAGE
        { u32x4 zr[4]; const bf16_t* zp_ = ZD + (size_t)(b * SEQ + 63 * 64 + (t2 >> 2)) * 2048 + h * 128 + 32 * (t2 & 3);
#pragma unroll
          for (int k = 0; k < 4; ++k) zr[k] = *(const u32x4*)(zp_ + 8 * k);
          dn_epilogue(t2, Ob + 16384, zr, nwl, OD, b * SEQ + 63 * 64, h); }
        LDS_BARRIER();
    }
#undef BLD16
}

#ifdef MK_ATTN_TAIL
#define MK_ATTN_LAST nfirst
#else
#define MK_ATTN_LAST natt
#endif
#ifndef REP_SCAN
#define REP_SCAN 1
#endif
#ifndef REP_ATTN
#define REP_ATTN 1
#endif
#ifndef REP_P0
#define REP_P0 1
#endif
#ifndef REP_P1
#define REP_P1 1
#endif
#ifndef REP_P2
#define REP_P2 1
#endif
#ifndef REP_P4
#define REP_P4 1
#endif
#ifndef REP_P6
#define REP_P6 1
#endif
#ifndef REP_P8
#define REP_P8 1
#endif
#ifndef REP_P9
#define REP_P9 1
#endif
#ifndef REP_P10
#define REP_P10 1
#endif
#ifndef WGM_IN
#define WGM_IN 8
#endif
#ifndef WGM_UP
#define WGM_UP 4
#endif
#ifndef WGM_SQ
#define WGM_SQ 4
#endif
#ifndef MK_STAGGER_IN
#define MK_STAGGER_IN 0
#endif
#ifndef MK_STAGGER_UP
#define MK_STAGGER_UP 0
#endif
__device__ __forceinline__ void stagger_delay(unsigned ticks) {
    const unsigned long long t0 = __builtin_amdgcn_s_memrealtime();
    while ((unsigned long long)__builtin_amdgcn_s_memrealtime() - t0 < (unsigned long long)ticks) __builtin_amdgcn_s_sleep(8);
}
__global__ void __launch_bounds__(NTHREADS, 2) mk_fwd(Args args) {
    extern __shared__ __attribute__((aligned(16))) unsigned char lds_raw[];
    Frame F;
    F.lds = (LAS unsigned char*)lds_raw;
    F.tid = threadIdx.x; F.lane = F.tid & 63; F.wave = __builtin_amdgcn_readfirstlane(F.tid >> 6);
    typedef const __attribute__((address_space(4))) Args* kargs_t;
    kargs_t ap = (kargs_t)__builtin_amdgcn_kernarg_segment_ptr();
    F.ws = ap->ws; F.x = (const float*)ap->in[0]; F.pos = (const int*)ap->in[1]; F.out = ap->out;
    unsigned* ctl = (unsigned*)(F.ws + WS_CTL);
    volatile LAS unsigned* MISC = (volatile LAS unsigned*)(F.lds + MISC_OFF);
#if MK_ONE_LAUNCH
    if (F.tid < 64) MISC[F.tid] = 0u;
    __syncthreads();
    XcdBarrier bar = xcd_barrier_post(ctl + CW_BAR, MISC);
#define GRID_BAR() xcd_barrier(bar)
#else
#define GRID_BAR() do { } while (0)
#endif
    const int lo = ap->ph_lo, hi = ap->ph_hi;
    const int G = (int)gridDim.x, bx = (int)blockIdx.x;
#define XN ((bf16_t*)(F.ws + WS_XN))
#define QA ((bf16_t*)(F.ws + WS_QA))
#define KA ((bf16_t*)(F.ws + WS_KA))
#define VA ((bf16_t*)(F.ws + WS_VA))
#define QKVD ((bf16_t*)(F.ws + WS_QKVD))
#define ZD ((bf16_t*)(F.ws + WS_ZD))
#define GA ((bf16_t*)(F.ws + WS_GA))
#define GD ((bf16_t*)(F.ws + WS_GD))
#define BAf ((float*)(F.ws + WS_BA))
#define ROPE ((float*)(F.ws + WS_ROPE))
#define Y GA
#define OA XN
#define MIX QKVD
#define UF QKVD
#define ACT ((bf16_t*)(F.ws + WS_DN))
#define FO QA
#define OD QKVD

    for (int l = 0; l < DEPTH; ++l) {
        const int pb = l * NPH;
#define IN(p) (lo <= pb + (p) && pb + (p) < hi)
#define REFRAME() do { int t_ = threadIdx.x; asm volatile("" : "+v"(t_)); F.tid = t_; F.lane = t_ & 63; F.wave = __builtin_amdgcn_readfirstlane(t_ >> 6); \
        ap = (kargs_t)__builtin_amdgcn_kernarg_segment_ptr(); asm volatile("" : "+s"(ap)); F.ws = ap->ws; F.x = (const float*)ap->in[0]; F.pos = (const int*)ap->in[1]; F.out = ap->out; } while (0)
#define SEAM(p) do { if (pb + (p) + 1 < hi) GRID_BAR(); } while (0)
#ifndef NO_P0
        if (IN(0)) { REFRAME();
            ph_convert_weights(F, ap, l);
            if (l == 0) { ph_rope_table(F); ph_norm_first(F, F.x, (const float*)ap->in[2], XN); }
            SEAM(0);
        }
#endif
#ifndef NO_P1
        if (IN(1)) { REFRAME();
#if MK_STAGGER_IN > 0
            if (bx & 1) stagger_delay(MK_STAGGER_IN);
#endif
            for (int rep_ = 0; rep_ < REP_P1; ++rep_) { pg8::Gemm g{XN, (const bf16_t*)(F.ws + WT_IN), T, NIN, D}; pg8::StaticOrder S; S.init(T, NIN, G, bx, WGM_IN);
            pg8::EpiInProj E{QA, KA, VA, QKVD, ZD, GA, GD, BAf, ROPE};
            pg8::gemm_phase<pg8::EpiInProj, pg8::StaticOrder, true, true, (MK_PRESTAGE & 1) != 0>(F.lds, g, S, E);
             }
            SEAM(1);
        }
#endif
#ifndef NO_P2
        if (IN(2)) { REFRAME();
            for (int rep_ = 0; rep_ < REP_P2; ++rep_) { ph_dn_prep(F, QKVD, BAf, (const float*)ap->in[5] + (size_t)l * 4 * 6144, (const float*)ap->in[6] + l * 16, (const float*)ap->in[7] + l * 16, F.ws + WS_DN);
 }
                        SEAM(2);
        }
#endif
#ifndef NO_P3
        if (IN(3)) { REFRAME();
            { const int half = G / 2;
              const int natt = NB * 32 * 4, nrnd = (G - half) > 0 ? (natt - half) / (G - half) : 0, nfirst = nrnd * (G - half);
              if (bx < half) { for (int rs_ = 0; rs_ < REP_SCAN; ++rs_) for (int it = bx; it < NB * 16; it += half) ph_dn_scan(F, it, ZD, OD, (const float*)ap->in[8] + l * 128, F.ws + WS_DN);
#ifdef MK_ATTN_TAIL
                  ph_attn(F, QA, OA, KA, VA, (const float*)ap->in[4] + l * 16, nfirst + bx, half, natt);
#endif
              }
              else { for (int ra_ = 0; ra_ < REP_ATTN; ++ra_) ph_attn(F, QA, OA, KA, VA, (const float*)ap->in[4] + l * 16, bx - half, G - half, MK_ATTN_LAST); } }
            SEAM(3);
        }
#endif
#ifndef NO_P4
        if (IN(4)) { REFRAME();
            for (int rep_ = 0; rep_ < REP_P4; ++rep_) { pg8::Gemm g{OA, (const bf16_t*)(F.ws + WT_BA), T, D, D}; pg8::StaticOrder S; S.init(T, D, G, bx, WGM_SQ);
            pg8::EpiGate<0> E{Y, GA};
            pg8::gemm_phase<pg8::EpiGate<0>, pg8::StaticOrder, true, true, (MK_PRESTAGE & 8) != 0>(F.lds, g, S, E);
             }
#if MK_SEAM4
            SEAM(4);
#endif
        }
#endif
#ifndef NO_P5
        if (IN(5)) { REFRAME();
            pg8::Gemm g{OD, (const bf16_t*)(F.ws + WT_BD), T, D, D}; pg8::StaticOrder S; S.init(T, D, G, bx, WGM_SQ);
            pg8::EpiGate<1> E{Y, GD};
            pg8::gemm_phase<pg8::EpiGate<1>, pg8::StaticOrder, true, true, (MK_PRESTAGE & 8) != 0>(F.lds, g, S, E);
            SEAM(5);
        }
#endif
#ifndef NO_P6
        if (IN(6)) { REFRAME();
            for (int rep_ = 0; rep_ < REP_P6; ++rep_) { pg8::Gemm g{Y, (const bf16_t*)(F.ws + WT_OUT), T, D, D}; pg8::StaticOrder S; S.init(T, D, G, bx, WGM_SQ);
            pg8::EpiPlain E{MIX, D};
            pg8::gemm_phase<pg8::EpiPlain, pg8::StaticOrder, true, true, (MK_PRESTAGE & 4) != 0>(F.lds, g, S, E);
             }
            SEAM(6);
        }
#endif
#ifndef NO_P7
        if (IN(7)) { REFRAME();
            if (l == 0) ph_norm_res<false, true>(F, MIX, (const float*)ap->in[12] + (size_t)l * D, F.x, F.out, (const float*)ap->in[13] + (size_t)l * D, XN);
            else ph_norm_res<true, true>(F, MIX, (const float*)ap->in[12] + (size_t)l * D, F.out, (l == DEPTH - 1) ? (void*)(F.ws + WS_HTAIL) : (void*)F.out, (const float*)ap->in[13] + (size_t)l * D, XN);
            SEAM(7);
        }
#endif
#ifndef NO_P8
        if (IN(8)) { REFRAME();
            for (int rep_ = 0; rep_ < REP_P8; ++rep_) { pg8::Gemm g{XN, (const bf16_t*)(F.ws + WT_UP), T, NUP, D}; pg8::StaticOrder S; S.init(T, NUP, G, bx, WGM_UP);
            pg8::EpiConvGlu E{ACT, (float*)(F.ws + WS_QKVD), (float*)(F.ws + WS_QKVD + 64 * MiB), (const float*)ap->in[15] + (size_t)l * 3 * NUP, (const float*)ap->in[16] + (size_t)l * NUP, F.lds + pg8::STAGE_BYTES};
            pg8::gemm_phase<pg8::EpiConvGlu, pg8::StaticOrder, true, true, (MK_PRESTAGE & 2) != 0>(F.lds, g, S, E);
             }
            SEAM(8);
        }
#endif
#ifndef NO_P9
        if (IN(9)) { REFRAME();
            for (int rep_ = 0; rep_ < REP_P9; ++rep_) { ph_ffn_fixup(F, (const float*)(F.ws + WS_QKVD), (const float*)(F.ws + WS_QKVD + 64 * MiB), (const float*)ap->in[15] + (size_t)l * 3 * NUP, ACT);
             }
            SEAM(9);
        }
#endif
#ifndef NO_P10
        if (IN(10)) { REFRAME();
            for (int rep_ = 0; rep_ < REP_P10; ++rep_) { pg8::Gemm g{ACT, (const bf16_t*)(F.ws + WT_DOWN), T, D, DFF}; pg8::StaticOrder S; S.init(T, D, G, bx, WGM_SQ);
            pg8::EpiPlain E{FO, D};
            pg8::gemm_phase<pg8::EpiPlain, pg8::StaticOrder, true, true, (MK_PRESTAGE & 4) != 0>(F.lds, g, S, E);
             }
#ifdef PROBE_DOWN_B
            { pg8::Gemm g{ACT, (const bf16_t*)(F.ws + WT_DOWN), 2 * T, D, D}; pg8::StaticOrder S; S.init(2 * T, D, G, bx, WGM_SQ);
#ifdef PROBE_DOWN_C
              pg8::EpiNull E{(bf16_t*)(F.ws + WS_QKVD), D};
              pg8::gemm_phase<pg8::EpiNull, pg8::StaticOrder, true, true>(F.lds, g, S, E); }
#else
              pg8::EpiPlain E{(bf16_t*)(F.ws + WS_QKVD), D};
              pg8::gemm_phase<pg8::EpiPlain, pg8::StaticOrder, true, true>(F.lds, g, S, E); }
#endif
#endif
            SEAM(10);
        }
#endif
#ifndef NO_P11
        if (IN(11)) { REFRAME();
            if (l + 1 < DEPTH) ph_norm_res<true, true>(F, FO, (const float*)ap->in[18] + (size_t)l * D, F.out, F.out, (const float*)ap->in[2] + (size_t)(l + 1) * D, XN);
            else ph_norm_res<true, false>(F, FO, (const float*)ap->in[18] + (size_t)l * D, F.ws + WS_HTAIL, F.out, nullptr, XN);
            SEAM(11);
        }
#endif
#undef IN
#undef REFRAME
#undef SEAM
    }
}
#undef XN
#undef QA
#undef KA
#undef VA
#undef QKVD
#undef ZD
#undef GA
#undef GD
#undef BAf
#undef ROPE
#undef Y
#undef OA
#undef MIX
#undef UF
#undef ACT
#undef FO
#undef OD

extern "C" void kernel_launch(void* const* d_in, const int* in_sizes, int n_in, void* d_out, int out_size, void* d_ws, size_t ws_size, hipStream_t stream) {
    static int grid = 0;
    if (grid == 0) {
        if (n_in != 19 || out_size != T * D || ws_size < WS_END) { fprintf(stderr, "kernel_launch: unexpected problem shape (n_in %d out %d ws %zu)\n", n_in, out_size, ws_size); grid = -1; return; }
        int dev = 0, cus = 0, per_cu = 0;
        if (hipGetDevice(&dev) != hipSuccess || hipDeviceGetAttribute(&cus, hipDeviceAttributeMultiprocessorCount, dev) != hipSuccess) { grid = -1; return; }
        if (hipFuncSetAttribute((const void*)mk_fwd, hipFuncAttributeMaxDynamicSharedMemorySize, LDS_BYTES) != hipSuccess) { fprintf(stderr, "kernel_launch: hipFuncSetAttribute failed\n"); grid = -1; return; }
        if (hipOccupancyMaxActiveBlocksPerMultiprocessor(&per_cu, (const void*)mk_fwd, NTHREADS, LDS_BYTES) != hipSuccess || per_cu < 1) fprintf(stderr, "kernel_launch: occupancy query reports %d\n", per_cu);
        (void)hipGetLastError();
        grid = cus;
    }
    if (grid < 0) return;
    if (hipMemsetAsync((char*)d_ws + WS_CTL, 0, CTL_ZERO_BYTES, stream) != hipSuccess) return;
    Args a{};
    for (int i = 0; i < 19; ++i) a.in[i] = d_in[i];
    a.out = (float*)d_out; a.ws = (unsigned char*)d_ws;
#if MK_ONE_LAUNCH
    a.ph_lo = 0; a.ph_hi = NPHASES;
    hipLaunchKernelGGL(mk_fwd, dim3(grid), dim3(NTHREADS), LDS_BYTES, stream, a);
#else
    for (int p = 0; p < NPHASES; ++p) { a.ph_lo = p; a.ph_hi = p + 1; hipLaunchKernelGGL(mk_fwd, dim3(grid), dim3(NTHREADS), LDS_BYTES, stream, a);
#ifdef MK_PROBE_DUP_PHASE
        if (p % NPH == MK_PROBE_DUP_PHASE) hipLaunchKernelGGL(mk_fwd, dim3(grid), dim3(NTHREADS), LDS_BYTES, stream, a);
#endif
    }
#endif
}
```
